# Optimizing an MI355X kernel written in HIP

```python
import jax, jax.numpy as jnp
from jax import lax
import numpy as np

D_MODEL = 1024
BATCH = 4
SEQ = 4096
DEPTH = 4

CHUNK = 64
Q_BLOCK = 128
N_MIXERS = 3
EXPAND = 2
D_INNER = EXPAND * D_MODEL
N_HEADS = 16
HEAD_DIM = D_INNER // N_HEADS
MLA_Q_RANK = 256
MLA_KV_RANK = 128
MLA_NOPE_DIM = 128
MLA_ROPE_DIM = 64
MLA_V_DIM = D_INNER // N_HEADS
ROPE_BASE = 10000.0
FORGET_BIAS = 3.0
EPS = 1e-6
NEG = -1e30

kernel_name = 'hybrid_stickbreak_mla_forgetting_trunk'


def rmsnorm(x, g):
    x32 = x.astype(jnp.float32)
    y = x32 * lax.rsqrt(jnp.mean(x32 * x32, axis=-1, keepdims=True) + EPS)
    return (y * g.astype(jnp.float32)).astype(x.dtype)


def split_heads(t, n_heads):
    b, s, _ = t.shape
    return t.reshape(b, s, n_heads, -1).transpose(0, 2, 1, 3)


def merge_heads(t):
    b, h, s, d = t.shape
    return t.transpose(0, 2, 1, 3).reshape(b, s, h * d)


def sweep_query_blocks(block_fn, seq):
    outs = [block_fn(start, start + Q_BLOCK) for start in range(0, seq, Q_BLOCK)]
    return jnp.concatenate(outs, axis=2)


def rope(x, positions):
    r = x.shape[-1]
    inv_freq = ROPE_BASE ** (-jnp.arange(0, r, 2, dtype=jnp.float32) / r)
    ang = positions.astype(jnp.float32)[:, :, None, None] * inv_freq
    cos, sin = jnp.cos(ang), jnp.sin(ang)
    x32 = x.astype(jnp.float32)
    x1, x2 = x32[..., : r // 2], x32[..., r // 2:]
    return jnp.concatenate([x1 * cos - x2 * sin, x1 * sin + x2 * cos], axis=-1).astype(x.dtype)


def stick_breaking_mixer(h, w_in, w_out):
    b, s, _ = h.shape
    q, k, v, gate = jnp.split(h @ w_in, 4, axis=-1)
    q, k, v = split_heads(q, N_HEADS), split_heads(k, N_HEADS), split_heads(v, N_HEADS)
    scale = HEAD_DIM ** -0.5

    def block(start, end):
        z = jnp.einsum('bhqd,bhkd->bhqk', q[:, :, start:end], k[:, :, :end],
                       preferred_element_type=jnp.float32) * scale
        strict = jnp.arange(end)[None, :] < jnp.arange(start, end)[:, None]
        log_skip = jnp.where(strict, jax.nn.log_sigmoid(-z), 0.0)
        later = lax.cumsum(log_skip, axis=3, reverse=True) - log_skip
        w = jnp.where(strict, jnp.exp(jax.nn.log_sigmoid(z) + later), 0.0)
        return jnp.einsum('bhqk,bhkd->bhqd', w.astype(v.dtype), v[:, :, :end])

    o = merge_heads(sweep_query_blocks(block, s))
    return (o * jax.nn.silu(gate)) @ w_out


def mla_mixer(h, positions, w_in, q_norm, w_qb, kv_norm, w_kvb, w_out):
    b, s, _ = h.shape
    i1 = MLA_Q_RANK
    i2 = i1 + MLA_KV_RANK
    i3 = i2 + MLA_ROPE_DIM
    proj = h @ w_in
    q_lat, kv_lat, k_rope, gate = proj[..., :i1], proj[..., i1:i2], proj[..., i2:i3], proj[..., i3:]
    q = (rmsnorm(q_lat, q_norm) @ w_qb).reshape(b, s, N_HEADS, MLA_NOPE_DIM + MLA_ROPE_DIM)
    q_nope = q[..., :MLA_NOPE_DIM].transpose(0, 2, 1, 3)
    q_rope = rope(q[..., MLA_NOPE_DIM:], positions).transpose(0, 2, 1, 3)
    kv = (rmsnorm(kv_lat, kv_norm) @ w_kvb).reshape(b, s, N_HEADS, MLA_NOPE_DIM + MLA_V_DIM)
    k_nope = kv[..., :MLA_NOPE_DIM].transpose(0, 2, 1, 3)
    v = kv[..., MLA_NOPE_DIM:].transpose(0, 2, 1, 3)
    k_rope = rope(k_rope[:, :, None, :], positions)[:, :, 0, :]
    scale = (MLA_NOPE_DIM + MLA_ROPE_DIM) ** -0.5

    def block(start, end):
        z = (jnp.einsum('bhqd,bhkd->bhqk', q_nope[:, :, start:end], k_nope[:, :, :end],
                        preferred_element_type=jnp.float32)
             + jnp.einsum('bhqr,bkr->bhqk', q_rope[:, :, start:end], k_rope[:, :end],
                          preferred_element_type=jnp.float32)) * scale
        allowed = (jnp.arange(end)[None, :] // CHUNK) <= (jnp.arange(start, end)[:, None] // CHUNK)
        p = jax.nn.softmax(jnp.where(allowed, z, NEG), axis=-1)
        return jnp.einsum('bhqk,bhkd->bhqd', p.astype(v.dtype), v[:, :, :end])

    o = merge_heads(sweep_query_blocks(block, s))
    return (o * jax.nn.silu(gate)) @ w_out


def forgetting_mixer(h, w_in, b_f, w_out):
    b, s, _ = h.shape
    proj = h @ w_in
    q = split_heads(proj[..., :D_INNER], N_HEADS)
    k = split_heads(proj[..., D_INNER:2 * D_INNER], N_HEADS)
    v = split_heads(proj[..., 2 * D_INNER:3 * D_INNER], N_HEADS)
    gate = proj[..., 3 * D_INNER:4 * D_INNER]
    f_logit = proj[..., 4 * D_INNER:].astype(jnp.float32) + b_f.astype(jnp.float32)
    cum_log_f = lax.cumsum(jax.nn.log_sigmoid(f_logit), axis=1).transpose(0, 2, 1)
    scale = HEAD_DIM ** -0.5

    def block(start, end):
        z = jnp.einsum('bhqd,bhkd->bhqk', q[:, :, start:end], k[:, :, :end],
                       preferred_element_type=jnp.float32) * scale
        z = z + cum_log_f[:, :, start:end, None] - cum_log_f[:, :, None, :end]
        causal = jnp.arange(end)[None, :] <= jnp.arange(start, end)[:, None]
        p = jax.nn.softmax(jnp.where(causal, z, NEG), axis=-1)
        return jnp.einsum('bhqk,bhkd->bhqd', p.astype(v.dtype), v[:, :, :end])

    o = merge_heads(sweep_query_blocks(block, s))
    return (o * jax.nn.silu(gate)) @ w_out


def setup_inputs(seed: int = 0) -> dict:
    key = jax.random.key(seed)
    ks = iter(jax.random.split(key, 32))

    def w(shape):
        return jax.random.normal(next(ks), shape, jnp.float32) * shape[0] ** -0.5

    def gain(n):
        return 1.0 + 0.02 * jax.random.normal(next(ks), (n,), jnp.float32)

    x = jax.random.normal(next(ks), (BATCH, SEQ, D_MODEL), jnp.float32)
    offsets = jax.random.randint(next(ks), (BATCH,), 0, 64) * CHUNK
    positions = (offsets[:, None] + jnp.arange(SEQ)[None, :]).astype(jnp.int32)
    mla_in = MLA_Q_RANK + MLA_KV_RANK + MLA_ROPE_DIM + D_INNER
    return {
        'x': x,
        'positions': positions,
        'ln0': gain(D_MODEL),
        'w_in0': w((D_MODEL, 4 * D_INNER)),
        'w_out0': w((D_INNER, D_MODEL)),
        'ln1': gain(D_MODEL),
        'w_in1': w((D_MODEL, mla_in)),
        'q_norm1': gain(MLA_Q_RANK),
        'w_qb1': w((MLA_Q_RANK, N_HEADS * (MLA_NOPE_DIM + MLA_ROPE_DIM))),
        'kv_norm1': gain(MLA_KV_RANK),
        'w_kvb1': w((MLA_KV_RANK, N_HEADS * (MLA_NOPE_DIM + MLA_V_DIM))),
        'w_out1': w((D_INNER, D_MODEL)),
        'ln2': gain(D_MODEL),
        'w_in2': w((D_MODEL, 4 * D_INNER + N_HEADS)),
        'b_f2': FORGET_BIAS + 0.1 * jax.random.normal(next(ks), (N_HEADS,), jnp.float32),
        'w_out2': w((D_INNER, D_MODEL)),
        'ln3': gain(D_MODEL),
        'w_in3': w((D_MODEL, 4 * D_INNER)),
        'w_out3': w((D_INNER, D_MODEL)),
        'final_norm': gain(D_MODEL),
    }


def reference(x, positions, ln0, w_in0, w_out0, ln1, w_in1, q_norm1, w_qb1, kv_norm1, w_kvb1,
              w_out1, ln2, w_in2, b_f2, w_out2, ln3, w_in3, w_out3, final_norm):
    layer_params = [
        (ln0, (w_in0, w_out0)),
        (ln1, (w_in1, q_norm1, w_qb1, kv_norm1, w_kvb1, w_out1)),
        (ln2, (w_in2, b_f2, w_out2)),
        (ln3, (w_in3, w_out3)),
    ]
    for i in range(DEPTH):
        ln, p = layer_params[i]
        h = rmsnorm(x, ln)
        kind = i % N_MIXERS
        if kind == 0:
            y = stick_breaking_mixer(h, *p)
        elif kind == 1:
            y = mla_mixer(h, positions, *p)
        else:
            y = forgetting_mixer(h, *p)
        x = x + y
    return rmsnorm(x, final_norm)
```

```cpp
#include <hip/hip_runtime.h>
#include <hip/hip_cooperative_groups.h>
#include <cstdio>
#include <cstdint>
#include <cmath>
namespace cg = cooperative_groups;
#ifndef MK_ONE_LAUNCH
#define MK_ONE_LAUNCH 1
#endif
namespace pg8 {
#define PG8_LAS __attribute__((address_space(3)))
typedef unsigned short bf16_t;
typedef short bf16x8 __attribute__((ext_vector_type(8)));
typedef float f32x4 __attribute__((ext_vector_type(4)));
typedef unsigned u32x4 __attribute__((ext_vector_type(4)));
constexpr int BM = 256, BK = 64, HALF = 128, HTB = HALF * BK * 2  , STAGE_BYTES = 8 * HTB, NXCD = 8, WGM = 8;

__host__ __device__ __forceinline__ int lds_byte(int r, int c) { const int st = (r >> 4) * 2 + (c >> 5), rr = r & 15, cc = c & 31, ob = rr * 64 + cc * 2; return st * 1024 + (ob ^ (((ob >> 9) & 1) << 5)); }
__host__ __device__ __forceinline__ void stage_rc(int b, int& R, int& C) { const int st = b / 1024, sb = b % 1024, swz = sb ^ (((sb >> 9) & 1) << 5); R = (st >> 1) * 16 + swz / 64; C = (st & 1) * 32 + (swz % 64) / 2; }
__host__ __device__ __forceinline__ int perm32(int rho) { const int n = rho >> 4, i = rho & 15; return 8 * (i >> 2) + 4 * n + (i & 3); }

struct Unit { int pm, pn; };
struct Gemm { const bf16_t* A; const bf16_t* Bt; int M, N, K; };

struct StaticOrder {
    int nM, nN, nwg, G, c;
    __host__ __device__ void init(int M, int N, int G_, int c_) { nM = M / BM; nN = N / BM; nwg = nM * nN; G = G_; c = c_; }
    __host__ __device__ bool next(int i, Unit& u) const {
        const long L = (long)i * G + c; if (L >= nwg) return false;
        int wgid = (int)L; { const int q = nwg / NXCD, r = nwg % NXCD, xcd = wgid % NXCD, off = wgid / NXCD; wgid = (xcd < r ? xcd * (q + 1) : r * (q + 1) + (xcd - r) * q) + off; }
        const int nig = WGM * nN, gid = wgid / nig, fm = gid * WGM, gsz = (nM - fm) < WGM ? (nM - fm) : WGM;
        u.pm = fm + ((wgid % nig) % gsz); u.pn = (wgid % nig) / gsz; return true;
    }
    __device__ __forceinline__ void a_ready(const Unit&) const {}
    __device__ __forceinline__ void done(const Unit&) const {}
};

__device__ __forceinline__ unsigned cvt_pk_bf16(float lo, float hi) { unsigned r; asm volatile("v_cvt_pk_bf16_f32 %0, %1, %2" : "=v"(r) : "v"(lo), "v"(hi)); return r; }
typedef float f32x2 __attribute__((ext_vector_type(2)));
__device__ __forceinline__ f32x2 gelu_pk(f32x2 v) {
    const f32x2 av = __builtin_elementwise_abs(v), d = av * 0.2316418882f + 1.0f;
    f32x2 t; t.x = __builtin_amdgcn_rcpf(d.x); t.y = __builtin_amdgcn_rcpf(d.y);
    f32x2 q = t * 0.5307027145f + (-0.7265760135f); q = q * t + 0.7107068705f; q = q * t + (-0.142248368f); q = q * t + 0.127414796f; q = q * t;
    const f32x2 s = (v * v) * (-0.72134752044f);
    f32x2 e; e.x = __builtin_amdgcn_exp2f(s.x); e.y = __builtin_amdgcn_exp2f(s.y);
    const f32x2 m = v * (q * e), r = v - m;
    f32x2 o; o.x = v.x < 0.f ? m.x : r.x; o.y = v.y < 0.f ? m.y : r.y; return o;
}

template <int ACT  > struct EpiBf16 {
    static constexpr bool PERM = true, AFTER_DRAIN = false; static_assert(ACT == 0 || ACT == 1, "EpiBf16: ACT is 0 (none) or 1 (gelu_pk)");
    bf16_t* O; int ldc; const float* bias; int split_cols; size_t split_stride; float scale0;
    __device__ __forceinline__ void operator()(const f32x4 (&acc)[2][2][4][2], const Unit& u, int wr, int wc, int fr, int fq) const {
        const int row0 = u.pm * BM + wr * 64 + fr; int colt = u.pn * BM; bf16_t* base = O;
        float sc = 1.f; if (split_cols) { const int t = colt / split_cols; base += (size_t)t * split_stride; colt -= t * split_cols; if (t == 0) sc = scale0; }
        const int col0 = colt + wc * 32 + 8 * fq, bcol0 = u.pn * BM + wc * 32 + 8 * fq;
        f32x4 bv[2][2];
#pragma unroll
        for (int bj = 0; bj < 2; ++bj)
#pragma unroll
            for (int n = 0; n < 2; ++n) bv[bj][n] = bias ? *(const f32x4*)(bias + bcol0 + bj * HALF + 4 * n) : (f32x4){0.f, 0.f, 0.f, 0.f};
#pragma unroll
        for (int ai = 0; ai < 2; ++ai)
#pragma unroll
            for (int m = 0; m < 4; ++m) { bf16_t* rowp = base + (size_t)(row0 + ai * HALF + m * 16) * ldc + col0;
#pragma unroll
                for (int bj = 0; bj < 2; ++bj) { f32x4 v0 = acc[ai][bj][m][0] + bv[bj][0], v1 = acc[ai][bj][m][1] + bv[bj][1];
                    if (ACT == 1) { f32x2 a = gelu_pk((f32x2){v0[0], v0[1]}), b = gelu_pk((f32x2){v0[2], v0[3]}), c = gelu_pk((f32x2){v1[0], v1[1]}), d = gelu_pk((f32x2){v1[2], v1[3]});
                        v0 = (f32x4){a.x, a.y, b.x, b.y}; v1 = (f32x4){c.x, c.y, d.x, d.y}; }
                    v0 = v0 * sc; v1 = v1 * sc; u32x4 w; w.x = cvt_pk_bf16(v0[0], v0[1]); w.y = cvt_pk_bf16(v0[2], v0[3]); w.z = cvt_pk_bf16(v1[0], v1[1]); w.w = cvt_pk_bf16(v1[2], v1[3]);
                    *(u32x4*)(rowp + bj * HALF) = w; } }
    }
};

struct PanelStats {
    unsigned* xbuf;
    unsigned* cnt;
    unsigned* tmo;
    int ntn; float eps;
    unsigned code;
    __device__ __forceinline__ bool run(const f32x4 (&v)[2][2][4][2], const Unit& u, int wr, int wc, int fr, int fq, PG8_LAS unsigned char* lds, int wid, int lane) const {
        typedef float f32x2v __attribute__((ext_vector_type(2)));
        PG8_LAS f32x2v* P = (PG8_LAS f32x2v*)lds;
        PG8_LAS f32x2v* S = (PG8_LAS f32x2v*)(lds + 8192);
        PG8_LAS unsigned* flag = (PG8_LAS unsigned*)(lds + 8192 + 2048);
#pragma unroll
        for (int ai = 0; ai < 2; ++ai)
#pragma unroll
            for (int m = 0; m < 4; ++m) {
                float s = 0.f;
#pragma unroll
                for (int bj = 0; bj < 2; ++bj)
#pragma unroll
                    for (int n = 0; n < 2; ++n) { const f32x4 x = v[ai][bj][m][n]; s += (x[0] + x[1]) + (x[2] + x[3]); }
                s += __shfl_xor(s, 16); s += __shfl_xor(s, 32);
                const float mw = s * (1.0f / 64.0f); float q = 0.f;
#pragma unroll
                for (int bj = 0; bj < 2; ++bj)
#pragma unroll
                    for (int n = 0; n < 2; ++n) { const f32x4 d = v[ai][bj][m][n] - mw; q += (d[0] * d[0] + d[1] * d[1]) + (d[2] * d[2] + d[3] * d[3]); }
                q += __shfl_xor(q, 16); q += __shfl_xor(q, 32);
                if (fq == 0) P[(ai * HALF + wr * 64 + m * 16 + fr) * 4 + wc] = (f32x2v){mw, q};
            }
        asm volatile("s_waitcnt lgkmcnt(0)" ::: "memory"); __builtin_amdgcn_s_barrier(); asm volatile("" ::: "memory");
#if defined(BROKEN_EXCHANGE_NO_WAIT)
#warning BROKEN CONTROL BUILD: the row-statistics exchange does not wait; results are wrong by design
        if (blockIdx.x >= 64) { const long long t0_ = clock64(); while (clock64() - t0_ < 60000) __builtin_amdgcn_s_sleep(8); }
#endif
        const int row = wid * 32 + (lane & 31);
        if (lane < 32) {
            const f32x2v a = P[row * 4 + 0], b = P[row * 4 + 1], c = P[row * 4 + 2], d = P[row * 4 + 3];
            const float mt = (a.x + b.x + c.x + d.x) * 0.25f;
            const float da = a.x - mt, db = b.x - mt, dc = c.x - mt, dd = d.x - mt;
            const float m2 = (a.y + b.y) + (c.y + d.y) + 64.0f * ((da * da + db * db) + (dc * dc + dd * dd));
            unsigned long long* slot = (unsigned long long*)xbuf + ((size_t)(u.pm * BM + row) * 4 + u.pn);
            __hip_atomic_store(slot, ((unsigned long long)__float_as_uint(m2) << 32) | __float_as_uint(mt), __ATOMIC_RELAXED, __HIP_MEMORY_SCOPE_AGENT);
        }
        asm volatile("s_waitcnt vmcnt(0)" ::: "memory");
        if (lane == 0) __hip_atomic_fetch_add(cnt + 64 * u.pm, 1u, __ATOMIC_RELAXED, __HIP_MEMORY_SCOPE_AGENT);
        if (wid == 0) {
            bool dead = false; const unsigned long long t0 = __builtin_amdgcn_s_memrealtime(); const unsigned want = 8u * (unsigned)ntn;
            for (;;) {
#if defined(BROKEN_EXCHANGE_NO_WAIT)
                break;
#endif
                if ((unsigned)__builtin_amdgcn_readfirstlane(__hip_atomic_load(cnt + 64 * u.pm, __ATOMIC_RELAXED, __HIP_MEMORY_SCOPE_AGENT)) >= want) break;
                if (__builtin_amdgcn_s_memrealtime() - t0 > 2000000ull) {
                    if (lane == 0) { unsigned expect = 0u; __hip_atomic_compare_exchange_strong(tmo + 1, &expect, code | (unsigned)(u.pm & 0xff), __ATOMIC_RELAXED, __ATOMIC_RELAXED, __HIP_MEMORY_SCOPE_AGENT);
                                     __hip_atomic_store(tmo, 1u, __ATOMIC_RELAXED, __HIP_MEMORY_SCOPE_AGENT); }
                    dead = true; break; }
                __builtin_amdgcn_s_sleep(2);
            }
            __builtin_amdgcn_fence(__ATOMIC_ACQUIRE, "agent");
            if (lane == 0) flag[0] = dead ? 1u : 0u;
        }
        asm volatile("s_waitcnt vmcnt(0) lgkmcnt(0)" ::: "memory"); __builtin_amdgcn_s_barrier(); asm volatile("" ::: "memory");
        const bool bad = flag[0] != 0u;
        if (lane < 32) {
            const unsigned long long* slot = (const unsigned long long*)xbuf + (size_t)(u.pm * BM + row) * 4; float mt[4], m2[4]; float ms = 0.f;
#pragma unroll
            for (int t = 0; t < 4; ++t) { if (t < ntn) { const unsigned long long w = __hip_atomic_load(slot + t, __ATOMIC_RELAXED, __HIP_MEMORY_SCOPE_AGENT); mt[t] = __uint_as_float((unsigned)w); m2[t] = __uint_as_float((unsigned)(w >> 32)); } else { mt[t] = 0.f; m2[t] = 0.f; } ms += mt[t]; }
            const float mean = ms / (float)ntn; float q = 0.f;
#pragma unroll
            for (int t = 0; t < 4; ++t) if (t < ntn) { const float dm = mt[t] - mean; q += m2[t] + 256.0f * dm * dm; }
            S[row] = (f32x2v){mean, 1.0f / sqrtf(q / (256.0f * (float)ntn) + eps)};
        }
        asm volatile("s_waitcnt lgkmcnt(0)" ::: "memory"); __builtin_amdgcn_s_barrier(); asm volatile("" ::: "memory");
        return bad;
    }
};
struct EpiLnRes {
    static constexpr bool PERM = false, AFTER_DRAIN = true;
    const float* base; float* out; int ldc; const float* bias; PanelStats st; unsigned poison;
    __device__ __forceinline__ void fused(f32x4 (&acc)[2][2][4][2], const Unit& u, int wr, int wc, int fr, int fq, PG8_LAS unsigned char* lds, int wid, int lane) const {
        typedef float f32x2v __attribute__((ext_vector_type(2)));
        const PG8_LAS f32x2v* S = (const PG8_LAS f32x2v*)(lds + 8192);
        const int col0 = u.pn * BM + wc * 32 + 4 * fq;
#pragma unroll
        for (int bj = 0; bj < 2; ++bj)
#pragma unroll
            for (int n = 0; n < 2; ++n) { const f32x4 bv = bias ? *(const f32x4*)(bias + col0 + bj * HALF + n * 16) : (f32x4){0.f, 0.f, 0.f, 0.f};
#pragma unroll
                for (int ai = 0; ai < 2; ++ai)
#pragma unroll
                    for (int m = 0; m < 4; ++m) acc[ai][bj][m][n] += bv; }
        f32x4 pre[4][2][2];
#pragma unroll
        for (int m = 0; m < 4; ++m) { const size_t off = (size_t)(u.pm * BM + wr * 64 + m * 16 + fr) * ldc + col0;
#pragma unroll
            for (int bj = 0; bj < 2; ++bj)
#pragma unroll
                for (int n = 0; n < 2; ++n) pre[m][bj][n] = *(const f32x4*)(base + off + bj * HALF + n * 16); }
        const bool bad = st.run(acc, u, wr, wc, fr, fq, lds, wid, lane) || poison != 0u;
        const float qnan = __builtin_nanf("");
#pragma unroll
        for (int ai = 0; ai < 2; ++ai)
#pragma unroll
            for (int m = 0; m < 4; ++m) { const int r = ai * HALF + wr * 64 + m * 16 + fr; const f32x2v sr = S[r]; const size_t off = (size_t)(u.pm * BM + r) * ldc + col0;
#pragma unroll
                for (int bj = 0; bj < 2; ++bj)
#pragma unroll
                    for (int n = 0; n < 2; ++n) { const f32x4 bs = ai == 0 ? pre[m][bj][n] : *(const f32x4*)(base + off + bj * HALF + n * 16); f32x4 o = bs + (acc[ai][bj][m][n] - sr.x) * sr.y;
                        if (bad) o = (f32x4){qnan, qnan, qnan, qnan}; *(f32x4*)(out + off + bj * HALF + n * 16) = o; }
                if (m & 1) asm volatile("" ::: "memory"); }
    }
};
struct EpiLnResLn {
    static constexpr bool PERM = false, AFTER_DRAIN = true;
    const float* base; float* out; bf16_t* xn; int ldc; const float* bias; PanelStats st1, st2; unsigned poison;
    __device__ __forceinline__ void fused(f32x4 (&acc)[2][2][4][2], const Unit& u, int wr, int wc, int fr, int fq, PG8_LAS unsigned char* lds, int wid, int lane) const {
        typedef float f32x2v __attribute__((ext_vector_type(2))); typedef unsigned u32x2v __attribute__((ext_vector_type(2)));
        const PG8_LAS f32x2v* S = (const PG8_LAS f32x2v*)(lds + 8192);
        const int col0 = u.pn * BM + wc * 32 + 4 * fq;
#pragma unroll
        for (int bj = 0; bj < 2; ++bj)
#pragma unroll
            for (int n = 0; n < 2; ++n) { const f32x4 bv = bias ? *(const f32x4*)(bias + col0 + bj * HALF + n * 16) : (f32x4){0.f, 0.f, 0.f, 0.f};
#pragma unroll
                for (int ai = 0; ai < 2; ++ai)
#pragma unroll
                    for (int m = 0; m < 4; ++m) acc[ai][bj][m][n] += bv; }
        bool bad = st1.run(acc, u, wr, wc, fr, fq, lds, wid, lane) || poison != 0u;
        const float qnan = __builtin_nanf("");
#pragma unroll
        for (int ai = 0; ai < 2; ++ai)
#pragma unroll
            for (int m = 0; m < 4; ++m) { const int r = ai * HALF + wr * 64 + m * 16 + fr; const f32x2v sr = S[r]; const size_t off = (size_t)(u.pm * BM + r) * ldc + col0;
#pragma unroll
                for (int bj = 0; bj < 2; ++bj)
#pragma unroll
                    for (int n = 0; n < 2; ++n) { const f32x4 bs = *(const f32x4*)(base + off + bj * HALF + n * 16); acc[ai][bj][m][n] = bs + (acc[ai][bj][m][n] - sr.x) * sr.y; }
                asm volatile("" : "+v"(acc[ai][0][m][0]), "+v"(acc[ai][0][m][1]), "+v"(acc[ai][1][m][0]), "+v"(acc[ai][1][m][1]));
                if (m & 1) asm volatile("" ::: "memory"); }
        const bool bad1 = bad;
        bad = st2.run(acc, u, wr, wc, fr, fq, lds, wid, lane) || bad;
#pragma unroll
        for (int ai = 0; ai < 2; ++ai)
#pragma unroll
            for (int m = 0; m < 4; ++m) { const int r = ai * HALF + wr * 64 + m * 16 + fr; const f32x2v sr = S[r]; const size_t off = (size_t)(u.pm * BM + r) * ldc + col0;
#pragma unroll
                for (int bj = 0; bj < 2; ++bj)
#pragma unroll
                    for (int n = 0; n < 2; ++n) { const f32x4 x1 = acc[ai][bj][m][n]; *(f32x4*)(out + off + bj * HALF + n * 16) = bad1 ? (f32x4){qnan, qnan, qnan, qnan} : x1;
                        const f32x4 o = (x1 - sr.x) * sr.y; u32x2v w; w.x = cvt_pk_bf16(o[0], o[1]); w.y = cvt_pk_bf16(o[2], o[3]);
                        if (bad) { w.x = 0x7fc07fc0u; w.y = 0x7fc07fc0u; } *(u32x2v*)(xn + off + bj * HALF + n * 16) = w; }
                asm volatile("" ::: "memory"); }
    }
};

template <class Epi, class Sched, bool ALIGN_EPI = false, bool SP2 = false>
__device__ __forceinline__ void gemm_phase(PG8_LAS unsigned char* lds, const Gemm g, const Sched& S, const Epi& E) {
    int tid_ = threadIdx.x; asm volatile("" : "+v"(tid_));
    const int tid = tid_, wid = __builtin_amdgcn_readfirstlane(tid >> 6), lane = tid & 63, wr = wid >> 2, wc = wid & 3, fr = lane & 15, fq = lane >> 4;
    const int K = g.K, nt = K / BK;
    unsigned voffA[2], voffB[2];
#pragma unroll
    for (int i = 0; i < 2; ++i) { int R, C; stage_rc(tid * 16 + i * 8192, R, C); const int Rb = Epi::PERM ? ((R & ~31) + perm32(R & 31)) : R;
        voffA[i] = (unsigned)(R * K + C) * 2u; voffB[i] = (unsigned)(Rb * K + C) * 2u; }
    const size_t kstep = (size_t)(BK * 2);
    const size_t hstep = (size_t)HALF * K * 2;
    const size_t tstep = 2 * hstep;
    const unsigned ldsw = (unsigned)wid * 1024u;
    const int aoff = lds_byte(wr * 64 + fr, fq * 8), boff = lds_byte(wc * 32 + fr, fq * 8);
#define PG8_SA(b, h) (((b) * 2 + (h)) * HTB)
#define PG8_SB(b, h) ((4 + (b) * 2 + (h)) * HTB)
#define PG8_STAGE(bufoff, gbase, voff) do { _Pragma("unroll") for (int _i = 0; _i < 2; ++_i) \
        __builtin_amdgcn_global_load_lds((const unsigned*)((const char*)(gbase) + (voff)[_i]), (PG8_LAS unsigned*)(lds + (bufoff) + ldsw + _i * 8192), 16, 0, 0); } while (0)
#define PG8_LDA(dst, b, h) do { _Pragma("unroll") for (int m = 0; m < 4; ++m) _Pragma("unroll") for (int k = 0; k < 2; ++k) dst[m][k] = *(const PG8_LAS bf16x8*)(lds + PG8_SA(b, h) + aoff + m * 2048 + k * 1024); } while (0)
#define PG8_LDB(dst, b, h) do { _Pragma("unroll") for (int n = 0; n < 2; ++n) _Pragma("unroll") for (int k = 0; k < 2; ++k) dst[n][k] = *(const PG8_LAS bf16x8*)(lds + PG8_SB(b, h) + boff + n * 2048 + k * 1024); } while (0)
#define PG8_MMA(ai, bj, At, Bt) do { __builtin_amdgcn_s_setprio(1); _Pragma("unroll") for (int m = 0; m < 4; ++m) _Pragma("unroll") for (int n = 0; n < 2; ++n) _Pragma("unroll") for (int k = 0; k < 2; ++k) \
        acc[ai][bj][m][n] = __builtin_amdgcn_mfma_f32_16x16x32_bf16(Bt[n][k], At[m][k], acc[ai][bj][m][n], 0, 0, 0); __builtin_amdgcn_s_setprio(0); } while (0)
#define PG8_WAIT_V(n) asm volatile("s_waitcnt vmcnt(" #n ")" ::: "memory")
#define PG8_WAIT_L(n) asm volatile("s_waitcnt lgkmcnt(" #n ")" ::: "memory")
#define PG8_BAR __builtin_amdgcn_s_barrier()
#define PG8_SCHED __builtin_amdgcn_sched_barrier(0)
    Unit cur, nxt; int ui = 0;
    if (!S.next(0, cur)) return;
    f32x4 acc[2][2][4][2];
#pragma unroll
    for (int a = 0; a < 2; ++a)
#pragma unroll
        for (int b = 0; b < 2; ++b)
#pragma unroll
            for (int m = 0; m < 4; ++m)
#pragma unroll
                for (int n = 0; n < 2; ++n) acc[a][b][m][n] = (f32x4){0.f, 0.f, 0.f, 0.f};
    bf16x8 At[4][2], B0[2][2], B1[2][2];
    const char* cA = (const char*)g.A + (size_t)cur.pm * tstep; const char* cB = (const char*)g.Bt + (size_t)cur.pn * tstep;
    S.a_ready(cur);
    if constexpr (SP2) {
        PG8_STAGE(PG8_SB(0, 0), cB, voffB); PG8_STAGE(PG8_SB(0, 1), cB + hstep, voffB); PG8_STAGE(PG8_SA(0, 0), cA, voffA); PG8_STAGE(PG8_SA(0, 1), cA + hstep, voffA);
        if (wr == 1) PG8_BAR;
        PG8_WAIT_V(2); PG8_BAR;
        PG8_STAGE(PG8_SB(1, 0), cB + kstep, voffB); PG8_STAGE(PG8_SA(1, 0), cA + kstep, voffA); PG8_STAGE(PG8_SB(1, 1), cB + hstep + kstep, voffB);
        PG8_WAIT_V(6); PG8_BAR;
    } else {
        PG8_STAGE(PG8_SB(0, 0), cB, voffB); PG8_STAGE(PG8_SA(0, 0), cA, voffA); PG8_STAGE(PG8_SB(0, 1), cB + hstep, voffB); PG8_STAGE(PG8_SA(0, 1), cA + hstep, voffA);
        if (wr == 1) PG8_BAR;
        PG8_WAIT_V(4); PG8_BAR;
        PG8_STAGE(PG8_SB(1, 0), cB + kstep, voffB); PG8_STAGE(PG8_SA(1, 0), cA + kstep, voffA); PG8_STAGE(PG8_SB(1, 1), cB + hstep + kstep, voffB);
        PG8_WAIT_V(6); PG8_BAR;
    }
    for (;;) {
        const bool has_next = S.next(ui + 1, nxt);
        const char* nA = has_next ? (const char*)g.A + (size_t)nxt.pm * tstep : cA; const char* nB = has_next ? (const char*)g.Bt + (size_t)nxt.pn * tstep : cB;
        for (int t = 0; t < nt; t += 2) {
            const bool last = (t == nt - 2);
            const char* a1 = cA + (size_t)(t + 1) * kstep;
            const char* a2 = last ? nA : cA + (size_t)(t + 2) * kstep; const char* b2 = last ? nB : cB + (size_t)(t + 2) * kstep;
            const char* a3 = a2 + kstep; const char* b3 = b2 + kstep;
            if (last && has_next) S.a_ready(nxt);
            if constexpr (SP2) {
            PG8_LDB(B0, 0, 0); PG8_LDB(B1, 0, 1); PG8_SCHED; PG8_LDA(At, 0, 0); PG8_STAGE(PG8_SA(1, 1), a1 + hstep, voffA);
            PG8_WAIT_V(8); PG8_WAIT_L(0); PG8_BAR; PG8_MMA(0, 0, At, B0); PG8_MMA(0, 1, At, B1); PG8_BAR; PG8_SCHED;
            PG8_LDA(At, 0, 1); PG8_STAGE(PG8_SB(0, 0), b2, voffB); PG8_STAGE(PG8_SB(0, 1), b2 + hstep, voffB); PG8_STAGE(PG8_SA(0, 0), a2, voffA);
            PG8_WAIT_V(8); PG8_WAIT_L(0); PG8_BAR; PG8_MMA(1, 0, At, B0); PG8_MMA(1, 1, At, B1); PG8_BAR; PG8_SCHED;
            PG8_LDB(B0, 1, 0); PG8_LDB(B1, 1, 1); PG8_SCHED; PG8_LDA(At, 1, 0); PG8_STAGE(PG8_SA(0, 1), a2 + hstep, voffA);
            PG8_WAIT_V(8); PG8_WAIT_L(0); PG8_BAR; PG8_MMA(0, 0, At, B0); PG8_MMA(0, 1, At, B1); PG8_BAR; PG8_SCHED;
            PG8_LDA(At, 1, 1); PG8_STAGE(PG8_SB(1, 0), b3, voffB); PG8_STAGE(PG8_SB(1, 1), b3 + hstep, voffB); PG8_STAGE(PG8_SA(1, 0), a3, voffA);
            PG8_WAIT_V(8); PG8_WAIT_L(0); PG8_BAR; PG8_MMA(1, 0, At, B0); PG8_MMA(1, 1, At, B1); PG8_BAR; PG8_SCHED;
            } else {
            PG8_LDB(B0, 0, 0); PG8_SCHED; PG8_LDA(At, 0, 0); PG8_STAGE(PG8_SA(1, 1), a1 + hstep, voffA);
            PG8_WAIT_L(8); PG8_BAR; PG8_WAIT_L(0); PG8_MMA(0, 0, At, B0); PG8_BAR; PG8_SCHED;
            PG8_LDB(B1, 0, 1); PG8_STAGE(PG8_SB(0, 0), b2, voffB);
            PG8_BAR; PG8_WAIT_L(0); PG8_MMA(0, 1, At, B1); PG8_BAR;
            PG8_LDA(At, 0, 1); PG8_STAGE(PG8_SA(0, 0), a2, voffA);
            PG8_BAR; PG8_WAIT_L(0); PG8_MMA(1, 0, At, B0); PG8_BAR; PG8_SCHED;
            PG8_STAGE(PG8_SB(0, 1), b2 + hstep, voffB);
            PG8_WAIT_V(6); PG8_BAR; PG8_MMA(1, 1, At, B1); PG8_BAR;
            PG8_LDB(B0, 1, 0); PG8_SCHED; PG8_LDA(At, 1, 0); PG8_STAGE(PG8_SA(0, 1), a2 + hstep, voffA);
            PG8_WAIT_L(8); PG8_BAR; PG8_WAIT_L(0); PG8_MMA(0, 0, At, B0); PG8_BAR; PG8_SCHED;
            PG8_LDB(B1, 1, 1); PG8_STAGE(PG8_SB(1, 0), b3, voffB);
            PG8_BAR; PG8_WAIT_L(0); PG8_MMA(0, 1, At, B1); PG8_BAR;
            PG8_LDA(At, 1, 1); PG8_STAGE(PG8_SA(1, 0), a3, voffA);
            PG8_BAR; PG8_WAIT_L(0); PG8_MMA(1, 0, At, B0); PG8_BAR; PG8_SCHED;
            PG8_STAGE(PG8_SB(1, 1), b3 + hstep, voffB);
            PG8_WAIT_V(6); PG8_BAR; PG8_MMA(1, 1, At, B1); PG8_BAR;
            }
        }
        if constexpr (ALIGN_EPI) { if (wr == 0) PG8_BAR; }
        if constexpr (!Epi::AFTER_DRAIN) { E(acc, cur, wr, wc, fr, fq); S.done(cur); }
        if (!has_next) break;
#pragma unroll
        for (int a = 0; a < 2; ++a)
#pragma unroll
            for (int b = 0; b < 2; ++b)
#pragma unroll
                for (int m = 0; m < 4; ++m)
#pragma unroll
                    for (int n = 0; n < 2; ++n) acc[a][b][m][n] = (f32x4){0.f, 0.f, 0.f, 0.f};
        cur = nxt; cA = nA; cB = nB; ++ui;
        if constexpr (ALIGN_EPI) { if (wr == 1) PG8_BAR; }
    }
    PG8_WAIT_V(0);
    if constexpr (!ALIGN_EPI) { if (wr == 0) PG8_BAR; }
    PG8_BAR;
    if constexpr (Epi::AFTER_DRAIN) { E.fused(acc, cur, wr, wc, fr, fq, lds, wid, lane); S.done(cur); }
#undef PG8_SA
#undef PG8_SB
#undef PG8_STAGE
#undef PG8_LDA
#undef PG8_LDB
#undef PG8_MMA
#undef PG8_WAIT_V
#undef PG8_WAIT_L
#undef PG8_BAR
#undef PG8_SCHED
}
}
#define LAS __attribute__((address_space(3)))
#define DI_ __device__ __forceinline__
typedef unsigned short bf16_t;
typedef short bf16x8 __attribute__((ext_vector_type(8)));
typedef float f32x4 __attribute__((ext_vector_type(4)));
typedef float f32x2 __attribute__((ext_vector_type(2)));
typedef float f32x16 __attribute__((ext_vector_type(16)));
typedef unsigned u32x4 __attribute__((ext_vector_type(4)));
typedef unsigned u32x2 __attribute__((ext_vector_type(2)));
typedef __bf16 hbf2 __attribute__((ext_vector_type(2)));

constexpr int T = 16384, DM = 1024, DI = 2048, SEQ = 4096, NB = 4, NH = 16;
constexpr float EPS = 1e-6f;
constexpr float LOG2E = 1.4426950408889634f, LN2 = 0.6931471805599453f;
constexpr size_t MiB = 1u << 20;
constexpr size_t WS_WB = 1 * MiB, WS_H = 22 * MiB, WS_Q = 54 * MiB, WS_K = 118 * MiB, WS_VT = 182 * MiB, WS_CS = 246 * MiB, WS_LF = 250 * MiB, WS_CUM = 251 * MiB, WS_END = 252 * MiB;
constexpr size_t WS_O = WS_Q, WS_LAT = WS_Q, WS_QG = 118 * MiB, WS_KG = 166 * MiB, WS_VTG = 198 * MiB, WS_QN = 230 * MiB, WS_KVN = 238 * MiB, WS_KR = 242 * MiB;
constexpr size_t WB_IN = 0, WB_O = (size_t)8192 * 1024;
constexpr size_t WB1_LAT = 0, WB1_G = (size_t)512 * 1024, WB1_Q = WB1_G + (size_t)2048 * 1024, WB1_K = WB1_Q + (size_t)3072 * 256, WB1_V = WB1_K + (size_t)2048 * 128, WB1_O = WB1_V + (size_t)2048 * 128;
constexpr int LDS_BYTES = 131072 + 1024;
constexpr int NPH = 25;

DI_ unsigned pk2(float a, float b) { f32x2 v = {a, b}; hbf2 r = __builtin_convertvector(v, hbf2); return __builtin_bit_cast(unsigned, r); }
DI_ float bf_lo(unsigned u) { return __uint_as_float(u << 16); }
DI_ float bf_hi(unsigned u) { return __uint_as_float(u & 0xffff0000u); }
DI_ float wave_sum(float v) {
#pragma unroll
    for (int o = 1; o < 64; o <<= 1) v += __shfl_xor(v, o);
    return v;
}
DI_ float silu_f(float x) { return x * __builtin_amdgcn_rcpf(1.0f + __builtin_amdgcn_exp2f(-x * LOG2E)); }
#define LDS_WAIT() asm volatile("s_waitcnt lgkmcnt(0)" ::: "memory")

namespace pg8 {
struct EpiGate {
    static constexpr bool PERM = true, AFTER_DRAIN = false;
    bf16_t* O; int ldc;
    __device__ __forceinline__ void operator()(const f32x4 (&acc)[2][2][4][2], const Unit& u, int wr, int wc, int fr, int fq) const {
        const int row0 = u.pm * BM + wr * 64 + fr, col0 = u.pn * BM + wc * 32 + 8 * fq;
#pragma unroll
        for (int ai = 0; ai < 2; ++ai)
#pragma unroll
            for (int m = 0; m < 4; ++m) { bf16_t* rowp = O + (size_t)(row0 + ai * HALF + m * 16) * ldc + col0;
#pragma unroll
                for (int bj = 0; bj < 2; ++bj) { const f32x4 v0 = acc[ai][bj][m][0], v1 = acc[ai][bj][m][1];
                    const u32x4 ov = *(const u32x4*)(rowp + bj * HALF); u32x4 w;
                    w.x = ::pk2(::bf_lo(ov.x) * ::silu_f(v0[0]), ::bf_hi(ov.x) * ::silu_f(v0[1]));
                    w.y = ::pk2(::bf_lo(ov.y) * ::silu_f(v0[2]), ::bf_hi(ov.y) * ::silu_f(v0[3]));
                    w.z = ::pk2(::bf_lo(ov.z) * ::silu_f(v1[0]), ::bf_hi(ov.z) * ::silu_f(v1[1]));
                    w.w = ::pk2(::bf_lo(ov.w) * ::silu_f(v1[2]), ::bf_hi(ov.w) * ::silu_f(v1[3]));
                    *(u32x4*)(rowp + bj * HALF) = w; } }
    }
};
template <bool HASBASE> struct EpiF32 {
    static constexpr bool PERM = false, AFTER_DRAIN = false;
    const float* base; float* out; int ldc;
    __device__ __forceinline__ void operator()(const f32x4 (&acc)[2][2][4][2], const Unit& u, int wr, int wc, int fr, int fq) const {
        const int row0 = u.pm * BM + wr * 64 + fr, col0 = u.pn * BM + wc * 32 + 4 * fq;
#pragma unroll
        for (int ai = 0; ai < 2; ++ai)
#pragma unroll
            for (int m = 0; m < 4; ++m) { const size_t off = (size_t)(row0 + ai * HALF + m * 16) * ldc + col0;
#pragma unroll
                for (int bj = 0; bj < 2; ++bj)
#pragma unroll
                    for (int n = 0; n < 2; ++n) { f32x4 v = acc[ai][bj][m][n]; if constexpr (HASBASE) v += *(const f32x4*)(base + off + bj * HALF + n * 16); *(f32x4*)(out + off + bj * HALF + n * 16) = v; } }
    }
};
}

DI_ void tr_item(const float* W, int ldw, int K, int k0, int col0, bf16_t* WT, int row0, LAS float* scr, int lane) {
#pragma unroll 8
    for (int i = 0; i < 32; ++i) { const int kk = 2 * i + (lane >> 5); scr[kk * 33 + (lane & 31)] = W[(size_t)(k0 + kk) * ldw + col0 + (lane & 31)]; }
    LDS_WAIT();
    const int c = lane & 7;
#pragma unroll
    for (int j = 0; j < 4; ++j) { const int n = (lane >> 3) + 8 * j; const LAS float* s = scr + (8 * c) * 33 + n;
        u32x4 o; o.x = pk2(s[0 * 33], s[1 * 33]); o.y = pk2(s[2 * 33], s[3 * 33]); o.z = pk2(s[4 * 33], s[5 * 33]); o.w = pk2(s[6 * 33], s[7 * 33]);
        *(u32x4*)(WT + (size_t)(row0 + n) * K + k0 + 8 * c) = o; }
    LDS_WAIT();
}
DI_ void conv_seg(const float* W, int ldw, int K, int col_start, int ncols, bf16_t* WT, int row_start, LAS float* scr, int gw, int NGW, int lane) {
    const int nblk = ncols / 32, nitems = (K / 64) * nblk;
    for (int it = gw; it < nitems; it += NGW) { const int kb = it / nblk, nb = it - kb * nblk; tr_item(W, ldw, K, 64 * kb, col_start + 32 * nb, WT, row_start + 32 * nb, scr, lane); }
}
struct AttnP { const bf16_t* Q; const bf16_t* K; const bf16_t* KR; const bf16_t* VT; bf16_t* O; const float* cum; const float* cs; int qpitch, kpitch, opitch, nh; };
#define MFMA32(a, b, c) __builtin_amdgcn_mfma_f32_32x32x16_bf16((a), (b), (c), 0, 0, 0)
DI_ bf16x8 pack8(float a0, float a1, float a2, float a3, float a4, float a5, float a6, float a7) {
    u32x4 w = {pk2(a0, a1), pk2(a2, a3), pk2(a4, a5), pk2(a6, a7)}; return __builtin_bit_cast(bf16x8, w);
}
DI_ float xhalf(float x) { return __shfl_xor(x, 32); }

template <int MODE>
DI_ void attn_unit(LAS unsigned char* lds, const AttnP& P, const int b, const int hh, const int qb) {
    constexpr int DK = MODE == 1 ? 192 : 128, NKS = DK / 16, KROW = DK * 2, KT_BYTES = 64 * KROW, VSTR = 136, VT_BYTES = 128 * VSTR;
    constexpr int CT_OFF = KT_BYTES + VT_BYTES, BUF = CT_OFF + 256, FLAG_OFF = 2 * BUF;
    int tid_ = threadIdx.x; asm volatile("" : "+v"(tid_));
    const int tid = tid_, wid = __builtin_amdgcn_readfirstlane(tid >> 6), lane = tid & 63, r32 = lane & 31, hi = lane >> 5;
    const int q0 = qb * 256, tq = q0 + wid * 32 + r32;
    const size_t tokq = (size_t)b * SEQ + tq;
    constexpr float SCALE = MODE == 1 ? 0.07216878364870322f : 0.08838834764831845f;
    constexpr float C2 = SCALE * LOG2E;
    bf16x8 qr[NKS];
    { const bf16_t* qp = P.Q + tokq * P.qpitch + hh * DK + hi * 8;
#pragma unroll
      for (int d0 = 0; d0 < NKS; ++d0) qr[d0] = *(const bf16x8*)(qp + d0 * 16); }
    if constexpr (MODE == 1) {
#pragma unroll
        for (int dd = 0; dd < 2; ++dd) {
            const float* cp = P.cs + tokq * 32 + 16 * dd + 8 * hi; const float* sp = cp + (size_t)T * 32;
            const f32x4 c0 = *(const f32x4*)cp, c1 = *(const f32x4*)(cp + 4), s0 = *(const f32x4*)sp, s1 = *(const f32x4*)(sp + 4);
            const u32x4 a = __builtin_bit_cast(u32x4, qr[8 + dd]), bb = __builtin_bit_cast(u32x4, qr[10 + dd]);
            float x1[8] = {bf_lo(a.x), bf_hi(a.x), bf_lo(a.y), bf_hi(a.y), bf_lo(a.z), bf_hi(a.z), bf_lo(a.w), bf_hi(a.w)};
            float x2[8] = {bf_lo(bb.x), bf_hi(bb.x), bf_lo(bb.y), bf_hi(bb.y), bf_lo(bb.z), bf_hi(bb.z), bf_lo(bb.w), bf_hi(bb.w)};
            float cc[8] = {c0[0], c0[1], c0[2], c0[3], c1[0], c1[1], c1[2], c1[3]}, ss[8] = {s0[0], s0[1], s0[2], s0[3], s1[0], s1[1], s1[2], s1[3]};
            float y1[8], y2[8];
#pragma unroll
            for (int i = 0; i < 8; ++i) { y1[i] = x1[i] * cc[i] - x2[i] * ss[i]; y2[i] = x1[i] * ss[i] + x2[i] * cc[i]; }
            qr[8 + dd] = pack8(y1[0], y1[1], y1[2], y1[3], y1[4], y1[5], y1[6], y1[7]);
            qr[10 + dd] = pack8(y2[0], y2[1], y2[2], y2[3], y2[4], y2[5], y2[6], y2[7]);
        }
    }
    const bf16_t* Kg = P.K + (size_t)b * SEQ * P.kpitch + hh * 128;
    const bf16_t* VTg = P.VT + (size_t)(hh * 128) * T + (size_t)b * SEQ;
    const int krow = tid >> 4, kc = tid & 15;
    const int ksw = MODE == 1 ? krow * KROW + ((kc ^ ((krow >> 1) & 7)) << 4) : krow * KROW + ((kc ^ (krow & 15)) << 4);
    const int rrow = tid >> 3, rc = tid & 7;
    const int rsw = rrow * KROW + (((16 + rc) ^ ((rrow >> 1) & 7)) << 4);
    const int vrow = tid >> 3, vc = tid & 7;
    const int vsw = KT_BYTES + vrow * VSTR + vc * 16;
    const int kfb = MODE == 1 ? r32 * KROW : r32 * KROW + ((hi ^ (r32 & 15)) << 4);
    const int kg16 = (hi ^ ((r32 >> 1) & 7)) << 4;
    const int vfb = KT_BYTES + r32 * VSTR + hi * 8;
    float ct = 0.f;
    if constexpr (MODE == 2) ct = P.cum[((size_t)b * NH + hh) * SEQ + tq];
    float m_run = -1e30f, l_run = 0.f, R = 0.f;
    f32x16 o[4];
#pragma unroll
    for (int d = 0; d < 4; ++d)
#pragma unroll
        for (int r = 0; r < 16; ++r) o[d][r] = 0.f;
    const int jd = (q0 >> 6) + (wid >> 1), jtop = (q0 >> 6) + 3;
    const int dq = (wid & 1) * 32 + r32;
    int j = MODE == 0 ? jtop : 0;
    bf16x8 sk0, sk1, skr, sv0, sv1; float scv = 0.f;
#define A_GLOAD(jj) do { const bf16_t* kp = Kg + (size_t)((jj) * 64 + krow) * P.kpitch + kc * 8; sk0 = *(const bf16x8*)kp; sk1 = *(const bf16x8*)(kp + (size_t)32 * P.kpitch); \
        if constexpr (MODE == 1) skr = *(const bf16x8*)(P.KR + ((size_t)b * SEQ + (jj) * 64 + rrow) * 64 + rc * 8); \
        const bf16_t* vp = VTg + (size_t)vrow * T + (jj) * 64 + vc * 8; sv0 = *(const bf16x8*)vp; sv1 = *(const bf16x8*)(vp + (size_t)64 * T); \
        if constexpr (MODE == 2) { if (tid < 64) scv = P.cum[((size_t)b * NH + hh) * SEQ + (jj) * 64 + tid]; } } while (0)
#define A_SWRITE(bufi) do { LAS unsigned char* bp = lds + (bufi) * BUF; *(LAS bf16x8*)(bp + ksw) = sk0; *(LAS bf16x8*)(bp + ksw + 32 * KROW) = sk1; \
        if constexpr (MODE == 1) *(LAS bf16x8*)(bp + rsw) = skr; \
        { const u32x4 a = __builtin_bit_cast(u32x4, sv0), c = __builtin_bit_cast(u32x4, sv1); \
          *(LAS u32x2*)(bp + vsw) = (u32x2){a.x, a.y}; *(LAS u32x2*)(bp + vsw + 8) = (u32x2){a.z, a.w}; \
          *(LAS u32x2*)(bp + vsw + 64 * VSTR) = (u32x2){c.x, c.y}; *(LAS u32x2*)(bp + vsw + 64 * VSTR + 8) = (u32x2){c.z, c.w}; } \
        if constexpr (MODE == 2) { if (tid < 64) *(LAS float*)(bp + CT_OFF + tid * 4) = scv; } } while (0)
    A_GLOAD(j); A_SWRITE(0); __syncthreads();
    bool wdone = false;
    for (int it = 0;; ++it) {
        const int cur = it & 1;
        const int jn = MODE == 0 ? j - 1 : j + 1;
        const bool pre = MODE == 0 ? (j > 0) : (j < jtop);
        if (pre) A_GLOAD(jn);
        const bool act = (j <= jd) && !wdone;
        if (act) {
            const LAS unsigned char* bp = lds + cur * BUF;
            f32x16 p0, p1;
#pragma unroll
            for (int r = 0; r < 16; ++r) { p0[r] = 0.f; p1[r] = 0.f; }
#pragma unroll
            for (int d0 = 0; d0 < NKS; ++d0) {
                const int ka = MODE == 1 ? kfb + ((d0 << 5) ^ kg16) : (kfb ^ (d0 << 5));
                const bf16x8 a0 = *(const LAS bf16x8*)(bp + ka), a1 = *(const LAS bf16x8*)(bp + ka + 32 * KROW);
                p0 = MFMA32(a0, qr[d0], p0); p1 = MFMA32(a1, qr[d0], p1);
                if ((d0 & 3) == 3) __builtin_amdgcn_sched_barrier(0);
            }
            const bool diag = (j == jd);
            if constexpr (MODE == 0) {
                float ls0[16], ls1[16];
#pragma unroll
                for (int r = 0; r < 16; ++r) {
                    const int kk = (r & 3) + 8 * (r >> 2) + 4 * hi;
                    { const float z = p0[r] * SCALE, e = __builtin_amdgcn_exp2f(-fabsf(z) * LOG2E), sp = fmaxf(z, 0.f) + __builtin_amdgcn_logf(1.0f + e) * LN2;
                      const bool ok = !diag || kk < dq; ls0[r] = ok ? -sp : 0.f; p0[r] = ok ? z - sp : -__builtin_inff(); }
                    { const float z = p1[r] * SCALE, e = __builtin_amdgcn_exp2f(-fabsf(z) * LOG2E), sp = fmaxf(z, 0.f) + __builtin_amdgcn_logf(1.0f + e) * LN2;
                      const bool ok = !diag || (kk + 32) < dq; ls1[r] = ok ? -sp : 0.f; p1[r] = ok ? z - sp : -__builtin_inff(); }
                }
                float gs[8], tot[8], ps[8];
#pragma unroll
                for (int g = 0; g < 4; ++g) { gs[g] = (ls0[4 * g] + ls0[4 * g + 1]) + (ls0[4 * g + 2] + ls0[4 * g + 3]); gs[4 + g] = (ls1[4 * g] + ls1[4 * g + 1]) + (ls1[4 * g + 2] + ls1[4 * g + 3]); }
#pragma unroll
                for (int i = 0; i < 8; ++i) { ps[i] = xhalf(gs[i]); tot[i] = gs[i] + ps[i]; }
                float suf = 0.f;
#pragma unroll
                for (int i = 7; i >= 0; --i) {
                    const float base = R + suf + (hi == 0 ? ps[i] : 0.f);
                    if (i >= 4) { const int g = i - 4;
                        const float l3 = base, l2 = l3 + ls1[4 * g + 3], l1 = l2 + ls1[4 * g + 2], l0 = l1 + ls1[4 * g + 1];
                        p1[4 * g + 3] = __builtin_amdgcn_exp2f((p1[4 * g + 3] + l3) * LOG2E); p1[4 * g + 2] = __builtin_amdgcn_exp2f((p1[4 * g + 2] + l2) * LOG2E);
                        p1[4 * g + 1] = __builtin_amdgcn_exp2f((p1[4 * g + 1] + l1) * LOG2E); p1[4 * g] = __builtin_amdgcn_exp2f((p1[4 * g] + l0) * LOG2E);
                    } else { const int g = i;
                        const float l3 = base, l2 = l3 + ls0[4 * g + 3], l1 = l2 + ls0[4 * g + 2], l0 = l1 + ls0[4 * g + 1];
                        p0[4 * g + 3] = __builtin_amdgcn_exp2f((p0[4 * g + 3] + l3) * LOG2E); p0[4 * g + 2] = __builtin_amdgcn_exp2f((p0[4 * g + 2] + l2) * LOG2E);
                        p0[4 * g + 1] = __builtin_amdgcn_exp2f((p0[4 * g + 1] + l1) * LOG2E); p0[4 * g] = __builtin_amdgcn_exp2f((p0[4 * g] + l0) * LOG2E);
                    }
                    suf += tot[i];
                }
                R += suf;
                wdone = __all(R < -88.0f) != 0;
            } else {
                if constexpr (MODE == 2) {
#pragma unroll
                    for (int g = 0; g < 4; ++g) {
                        const f32x4 ck0 = *(const LAS f32x4*)(bp + CT_OFF + g * 32 + hi * 16), ck1 = *(const LAS f32x4*)(bp + CT_OFF + 128 + g * 32 + hi * 16);
#pragma unroll
                        for (int e = 0; e < 4; ++e) { const int r = 4 * g + e, kk = 8 * g + 4 * hi + e;
                            float y0 = fmaf(p0[r], C2, (ct - ck0[e]) * LOG2E), y1 = fmaf(p1[r], C2, (ct - ck1[e]) * LOG2E);
                            if (diag) { if (kk > dq) y0 = -__builtin_inff(); if (kk + 32 > dq) y1 = -__builtin_inff(); }
                            p0[r] = y0; p1[r] = y1; }
                    }
                } else {
#pragma unroll
                    for (int r = 0; r < 16; ++r) { p0[r] *= C2; p1[r] *= C2; }
                }
                float pmax = p0[0];
#pragma unroll
                for (int r = 1; r < 16; ++r) pmax = fmaxf(pmax, p0[r]);
#pragma unroll
                for (int r = 0; r < 16; ++r) pmax = fmaxf(pmax, p1[r]);
                pmax = fmaxf(pmax, xhalf(pmax));
                const float mn = fmaxf(m_run, pmax), alpha = __builtin_amdgcn_exp2f(m_run - mn);
                m_run = mn;
                float psum = 0.f;
#pragma unroll
                for (int r = 0; r < 16; ++r) { p0[r] = __builtin_amdgcn_exp2f(p0[r] - mn); p1[r] = __builtin_amdgcn_exp2f(p1[r] - mn); psum += p0[r] + p1[r]; }
                l_run = l_run * alpha + psum;
                if (__any(alpha != 1.0f)) {
#pragma unroll
                    for (int d = 0; d < 4; ++d)
#pragma unroll
                        for (int r = 0; r < 16; ++r) o[d][r] *= alpha;
                }
            }
            bf16x8 pb[4];
            pb[0] = pack8(p0[0], p0[1], p0[2], p0[3], p0[4], p0[5], p0[6], p0[7]); pb[1] = pack8(p0[8], p0[9], p0[10], p0[11], p0[12], p0[13], p0[14], p0[15]);
            pb[2] = pack8(p1[0], p1[1], p1[2], p1[3], p1[4], p1[5], p1[6], p1[7]); pb[3] = pack8(p1[8], p1[9], p1[10], p1[11], p1[12], p1[13], p1[14], p1[15]);
#pragma unroll
            for (int d = 0; d < 4; ++d)
#pragma unroll
                for (int s = 0; s < 4; ++s) {
                    const u32x2 lo = *(const LAS u32x2*)(bp + vfb + d * 32 * VSTR + s * 32), h2 = *(const LAS u32x2*)(bp + vfb + d * 32 * VSTR + s * 32 + 16);
                    const u32x4 av = {lo.x, lo.y, h2.x, h2.y};
                    o[d] = MFMA32(__builtin_bit_cast(bf16x8, av), pb[s], o[d]);
                }
        }
        if constexpr (MODE == 0) { if (lane == 0) *(LAS unsigned*)(lds + FLAG_OFF + (cur * 8 + wid) * 4) = wdone ? 1u : 0u; }
        if (pre) A_SWRITE(cur ^ 1);
        __syncthreads();
        bool alldone = false;
        if constexpr (MODE == 0) { const u32x4 f0 = *(const LAS u32x4*)(lds + FLAG_OFF + cur * 32), f1 = *(const LAS u32x4*)(lds + FLAG_OFF + cur * 32 + 16);
            alldone = (f0.x & f0.y & f0.z & f0.w & f1.x & f1.y & f1.z & f1.w) != 0u; }
        if (!pre || alldone) break;
        j = jn;
    }
#undef A_GLOAD
#undef A_SWRITE
    if constexpr (MODE != 0) { const float lt = l_run + xhalf(l_run), inv = 1.0f / lt;
#pragma unroll
        for (int d = 0; d < 4; ++d)
#pragma unroll
            for (int r = 0; r < 16; ++r) o[d][r] *= inv; }
    bf16_t* op = P.O + tokq * P.opitch + hh * 128 + 4 * hi;
#pragma unroll
    for (int d = 0; d < 4; ++d)
#pragma unroll
        for (int g = 0; g < 4; ++g) *(u32x2*)(op + d * 32 + 8 * g) = (u32x2){pk2(o[d][4 * g], o[d][4 * g + 1]), pk2(o[d][4 * g + 2], o[d][4 * g + 3])};
}
template <int MODE>
DI_ void attn_phase(LAS unsigned char* lds, const AttnP& P, int G, int bid) {
    if constexpr (MODE == 0) { const int total = 4 * P.nh * 16;
        for (int L = bid; L < total; L += G) { const int qb = (L >> 3) & 15, bh = (L & 7) + 8 * (L >> 7); attn_unit<MODE>(lds, P, bh / P.nh, bh % P.nh, qb); }
    } else { const int total = 4 * P.nh * 16;
        for (int L2 = 2 * bid; L2 < total; L2 += (L2 & 1) ? 2 * G - 1 : 1) { const int L = L2 >> 1, x = (L >> 3) & 7, bh = (L & 7) + 8 * (L >> 6);
            attn_unit<MODE>(lds, P, bh / P.nh, bh % P.nh, (L2 & 1) ? 15 - x : x); }
    }
}
struct Params { const float* in[20]; float* out; unsigned char* ws; int ph_lo, ph_hi; };
#ifndef DBG_MASK
#define DBG_MASK 0xFFFF
#endif
#define EN(k) (((DBG_MASK) >> (k)) & 1)
enum { SUB_N = 0, SUB_G1 = 1, SUB_A = 2, SUB_G3 = 3, SUB_G4 = 4, SUB_GLAT = 5, SUB_N1B = 6, SUB_G2 = 7, SUB_FINAL = 9 };

typedef const __attribute__((address_space(4))) Params* KParams;
DI_ KParams kparams() { auto kp = __builtin_amdgcn_kernarg_segment_ptr(); asm volatile("" : "+s"(kp)); return (KParams)kp; }
#define WSPTRS() KParams kp_ = kparams(); unsigned char* ws = kp_->ws; float* xout = kp_->out; \
    bf16_t* WB = (bf16_t*)(ws + WS_WB); bf16_t* Hb = (bf16_t*)(ws + WS_H); bf16_t* Qb = (bf16_t*)(ws + WS_Q); bf16_t* Kb = (bf16_t*)(ws + WS_K); bf16_t* VTb = (bf16_t*)(ws + WS_VT); \
    float* CS = (float*)(ws + WS_CS); float* LF = (float*)(ws + WS_LF); float* CUM = (float*)(ws + WS_CUM); \
    float* LAT = (float*)(ws + WS_LAT); bf16_t* QG = (bf16_t*)(ws + WS_QG); bf16_t* KG = (bf16_t*)(ws + WS_KG); bf16_t* VTG = (bf16_t*)(ws + WS_VTG); \
    bf16_t* QN = (bf16_t*)(ws + WS_QN); bf16_t* KVN = (bf16_t*)(ws + WS_KVN); bf16_t* KR = (bf16_t*)(ws + WS_KR); \
    const float* xin = (l == 0) ? kp_->in[0] : xout; \
    (void)WB; (void)Hb; (void)Qb; (void)Kb; (void)VTb; (void)CS; (void)LF; (void)CUM; (void)LAT; (void)QG; (void)KG; (void)VTG; (void)QN; (void)KVN; (void)KR; (void)xin; (void)xout
#define PIN(i) (kp_->in[i])
__global__ void __launch_bounds__(512) fwd_megakernel(Params p) {
    extern __shared__ __attribute__((aligned(16))) unsigned char lds_raw[];
    LAS unsigned char* lds = (LAS unsigned char*)lds_raw;
    cg::grid_group grid = cg::this_grid();
    const int G = gridDim.x, bid = blockIdx.x, NGW = G * 8;
    const int ph_hi = p.ph_hi;
    for (int ph = p.ph_lo; ph < ph_hi; ++ph) {
        int tid_ = threadIdx.x; asm volatile("" : "+v"(tid_));
        const int tid = tid_, lane = tid & 63, wave = __builtin_amdgcn_readfirstlane(tid >> 6), gw = bid * 8 + wave;
        int l, sub, grp = 0;
        if (ph < 5) { l = 0; sub = ph; }
        else if (ph < 14) { l = 1; const int s = ph - 5; sub = s == 0 ? SUB_N : s == 1 ? SUB_GLAT : s == 2 ? SUB_N1B : (s == 3 || s == 5) ? SUB_G2 : (s == 4 || s == 6) ? SUB_A : s == 7 ? SUB_G3 : SUB_G4; grp = (s >= 5) ? 1 : 0; }
        else if (ph < 19) { l = 2; sub = ph - 14; }
        else if (ph < 24) { l = 3; sub = ph - 19; }
        else { l = 4; sub = SUB_FINAL; }

        if (EN(0) && sub == SUB_N) { WSPTRS();
            LAS float* scr = (LAS float*)(lds + wave * 16384);
            if (l == 0) {
                const int* pos = (const int*)PIN(1);
                for (int idx = bid * 512 + tid; idx < T * 32; idx += G * 512) { const int tok = idx >> 5, i = idx & 31;
                    const float invf = powf(10000.0f, -(float)(2 * i) / 64.0f); const float ang = (float)pos[tok] * invf;
                    const double ad = (double)ang, kq = rint(ad * 0.15915494309189535); const float rf = (float)(ad - kq * 6.283185307179586);
                    CS[idx] = cosf(rf); CS[(size_t)T * 32 + idx] = sinf(rf); }
            }
            if (l == 1) {
                const float* w_in = PIN(6);
                conv_seg(w_in, 2496, 1024, 0, 448, WB + WB1_LAT, 0, scr, gw, NGW, lane);
                for (int idx = bid * 512 + tid; idx < 64 * 1024 / 8; idx += G * 512) *(u32x4*)(WB + WB1_LAT + (size_t)448 * 1024 + (size_t)idx * 8) = (u32x4){0u, 0u, 0u, 0u};
                conv_seg(w_in, 2496, 1024, 448, 2048, WB + WB1_G, 0, scr, gw, NGW, lane);
                conv_seg(PIN(8), 3072, 256, 0, 3072, WB + WB1_Q, 0, scr, gw, NGW, lane);
                for (int it = gw; it < 256; it += NGW) { const int kb = it >> 7, nb = it & 127, col0 = 32 * nb, head = col0 >> 8, within = col0 & 255;
                    tr_item(PIN(10), 4096, 128, 64 * kb, col0, WB + (within >= 128 ? WB1_V : WB1_K), head * 128 + (within & 127), scr, lane); }
                conv_seg(PIN(11), 1024, 2048, 0, 1024, WB + WB1_O, 0, scr, gw, NGW, lane);
            } else {
                const float* w_in = l == 0 ? PIN(3) : l == 2 ? PIN(13) : PIN(17); const float* w_out = l == 0 ? PIN(4) : l == 2 ? PIN(15) : PIN(18);
                conv_seg(w_in, l == 2 ? 8208 : 8192, 1024, 0, 8192, WB + WB_IN, 0, scr, gw, NGW, lane);
                conv_seg(w_out, 1024, 2048, 0, 1024, WB + WB_O, 0, scr, gw, NGW, lane);
            }
            const float* gain = l == 0 ? PIN(2) : l == 1 ? PIN(5) : l == 2 ? PIN(12) : PIN(16);
            LAS float* wfl = (LAS float*)lds;
            if (l == 2) { __syncthreads();
                for (int idx = tid; idx < 16384; idx += 512) { const int k = idx >> 4, jj = idx & 15; wfl[jj * 1024 + k] = PIN(13)[(size_t)k * 8208 + 8192 + jj]; }
                __syncthreads(); }
            for (int m = gw; m < T; m += NGW) {
                const float* xr = xin + (size_t)m * DM + 4 * lane; f32x4 v[4]; float s = 0.f;
#pragma unroll
                for (int jj = 0; jj < 4; ++jj) { v[jj] = *(const f32x4*)(xr + 256 * jj); s += (v[jj].x * v[jj].x + v[jj].y * v[jj].y) + (v[jj].z * v[jj].z + v[jj].w * v[jj].w); }
                const float r = 1.0f / sqrtf(wave_sum(s) * (1.0f / DM) + EPS);
#pragma unroll
                for (int jj = 0; jj < 4; ++jj) { const f32x4 gg = *(const f32x4*)(gain + 4 * lane + 256 * jj); v[jj] = (v[jj] * r) * gg;
                    *(u32x2*)(Hb + (size_t)m * DM + 4 * lane + 256 * jj) = (u32x2){pk2(v[jj].x, v[jj].y), pk2(v[jj].z, v[jj].w)}; }
                if (l == 2) { float mine = 0.f;
#pragma unroll 4
                    for (int jh = 0; jh < 16; ++jh) { float a = 0.f;
#pragma unroll
                        for (int jj = 0; jj < 4; ++jj) { const f32x4 w = *(const LAS f32x4*)(wfl + jh * 1024 + 4 * lane + 256 * jj); a += (v[jj].x * w.x + v[jj].y * w.y) + (v[jj].z * w.z + v[jj].w * w.w); }
                        a = wave_sum(a); if (lane == jh) mine = a; }
                    if (lane < 16) { const float f = mine + PIN(14)[lane]; LF[(size_t)m * 16 + lane] = -(fmaxf(-f, 0.f) + log1pf(expf(-fabsf(f)))); } }
            }
            if (l == 2) __syncthreads();
        } else if (EN(1) && (sub == SUB_G1 || sub == SUB_G2)) { WSPTRS();
            if (l == 2 && bid < 64) {
                const int b = bid >> 4, h = bid & 15; float v[8]; float run = 0.f;
#pragma unroll
                for (int e = 0; e < 8; ++e) { run += LF[((size_t)b * SEQ + 8 * tid + e) * 16 + h]; v[e] = run; }
                float inc = run;
#pragma unroll
                for (int o = 1; o < 64; o <<= 1) { const float t = __shfl_up(inc, o); if (lane >= o) inc += t; }
                LAS float* wt = (LAS float*)lds;
                if (lane == 63) wt[wave] = inc;
                __syncthreads();
                float off = inc - run;
                for (int w = 0; w < wave; ++w) off += wt[w];
                float* cp = CUM + ((size_t)b * NH + h) * SEQ + 8 * tid;
                *(f32x4*)cp = (f32x4){v[0] + off, v[1] + off, v[2] + off, v[3] + off}; *(f32x4*)(cp + 4) = (f32x4){v[4] + off, v[5] + off, v[6] + off, v[7] + off};
                __syncthreads();
            }
            const int ng = sub == SUB_G1 ? 2 : 3;
            for (int gi = 0; gi < ng; ++gi) {
                pg8::Gemm g; pg8::EpiBf16<0> E; E.bias = nullptr; E.scale0 = 1.f; E.split_cols = 0; E.split_stride = 0;
                if (sub == SUB_G1) {
                    if (gi == 0) { g = pg8::Gemm{Hb, WB + WB_IN, T, 4096, 1024}; E.O = Qb; E.ldc = 2048; E.split_cols = 2048; E.split_stride = (size_t)(WS_K - WS_Q) / 2; }
                    else { g = pg8::Gemm{WB + WB_IN + (size_t)4096 * 1024, Hb, 2048, T, 1024}; E.O = VTb; E.ldc = T; }
                } else {
                    if (gi == 0) { g = pg8::Gemm{QN, WB + WB1_Q + (size_t)grp * 1536 * 256, T, 1536, 256}; E.O = QG; E.ldc = 1536; }
                    else if (gi == 1) { g = pg8::Gemm{KVN, WB + WB1_K + (size_t)grp * 1024 * 128, T, 1024, 128}; E.O = KG; E.ldc = 1024; }
                    else { g = pg8::Gemm{WB + WB1_V + (size_t)grp * 1024 * 128, KVN, 1024, T, 128}; E.O = VTG; E.ldc = T; }
                }
                pg8::StaticOrder S; S.init(g.M, g.N, G, bid);
                pg8::gemm_phase<pg8::EpiBf16<0>, pg8::StaticOrder, true, true>(lds, g, S, E);
            }
        } else if (EN(2) && sub == SUB_GLAT) { WSPTRS();
            pg8::Gemm g{Hb, WB + WB1_LAT, T, 512, 1024}; pg8::EpiF32<false> E{nullptr, LAT, 512};
            pg8::StaticOrder S; S.init(g.M, g.N, G, bid);
            pg8::gemm_phase<pg8::EpiF32<false>, pg8::StaticOrder, true, true>(lds, g, S, E);
        } else if (EN(9) && sub == SUB_G4) { WSPTRS();
            bf16_t* A = Qb;
            pg8::Gemm g{A, WB + (l == 1 ? WB1_O : WB_O), T, 1024, 2048}; pg8::EpiF32<true> E{xin, xout, 1024};
            pg8::StaticOrder S; S.init(g.M, g.N, G, bid);
            pg8::gemm_phase<pg8::EpiF32<true>, pg8::StaticOrder, true, true>(lds, g, S, E);
        } else if (EN(3) && sub == SUB_G3) { WSPTRS();
            pg8::Gemm g{Hb, WB + (l == 1 ? WB1_G : WB_IN + (size_t)6144 * 1024), T, 2048, 1024}; pg8::EpiGate E{Qb, 2048};
            pg8::StaticOrder S; S.init(g.M, g.N, G, bid);
            pg8::gemm_phase<pg8::EpiGate, pg8::StaticOrder, true, true>(lds, g, S, E);
        } else if (EN(4) && sub == SUB_N1B) { WSPTRS();
            for (int m = gw; m < T; m += NGW) {
                const float* row = LAT + (size_t)m * 512;
                const f32x4 a = *(const f32x4*)(row + 4 * lane), bq = *(const f32x4*)(row + 256 + 4 * lane);
                const float rq = 1.0f / sqrtf(wave_sum((a.x * a.x + a.y * a.y) + (a.z * a.z + a.w * a.w)) * (1.0f / 256.0f) + EPS);
                const f32x4 gq = *(const f32x4*)(PIN(7) + 4 * lane); const f32x4 yq = (a * rq) * gq;
                *(u32x2*)(QN + (size_t)m * 256 + 4 * lane) = (u32x2){pk2(yq.x, yq.y), pk2(yq.z, yq.w)};
                const float sk = lane < 32 ? (bq.x * bq.x + bq.y * bq.y) + (bq.z * bq.z + bq.w * bq.w) : 0.f;
                const float rk = 1.0f / sqrtf(wave_sum(sk) * (1.0f / 128.0f) + EPS);
                if (lane < 32) { const f32x4 gk = *(const f32x4*)(PIN(9) + 4 * lane); const f32x4 yk = (bq * rk) * gk;
                    *(u32x2*)(KVN + (size_t)m * 128 + 4 * lane) = (u32x2){pk2(yk.x, yk.y), pk2(yk.z, yk.w)}; }
                f32x4 pr; pr.x = __shfl_xor(bq.x, 8); pr.y = __shfl_xor(bq.y, 8); pr.z = __shfl_xor(bq.z, 8); pr.w = __shfl_xor(bq.w, 8);
                if (lane >= 32 && lane < 48) { const int i0 = 4 * (lane & 7); const bool second = lane >= 40;
                    const f32x4 c = *(const f32x4*)(CS + (size_t)m * 32 + i0), s = *(const f32x4*)(CS + (size_t)T * 32 + (size_t)m * 32 + i0);
                    const f32x4 x1 = second ? pr : bq, x2 = second ? bq : pr;
                    const f32x4 y = second ? (x1 * s + x2 * c) : (x1 * c - x2 * s);
                    *(u32x2*)(KR + (size_t)m * 64 + 4 * (lane - 32)) = (u32x2){pk2(y.x, y.y), pk2(y.z, y.w)}; }
            }
        } else if (sub == SUB_A) { WSPTRS();
            AttnP P; P.cum = CUM; P.cs = CS; P.KR = KR;
            if (EN(6) && l == 1) { P.Q = QG; P.K = KG; P.VT = VTG; P.O = Qb + grp * 1024; P.qpitch = 1536; P.kpitch = 1024; P.opitch = 2048; P.nh = 8; attn_phase<1>(lds, P, G, bid); }
            else { P.Q = Qb; P.K = Kb; P.VT = VTb; P.O = Qb; P.qpitch = 2048; P.kpitch = 2048; P.opitch = 2048; P.nh = 16;
                if (EN(7) && l == 2) attn_phase<2>(lds, P, G, bid); else if (EN(5)) attn_phase<0>(lds, P, G, bid); }
        } else if (EN(8)) { WSPTRS();
            for (int m = gw; m < T; m += NGW) {
                float* xr = xout + (size_t)m * DM + 4 * lane; f32x4 v[4]; float s = 0.f;
#pragma unroll
                for (int jj = 0; jj < 4; ++jj) { v[jj] = *(const f32x4*)(xr + 256 * jj); s += (v[jj].x * v[jj].x + v[jj].y * v[jj].y) + (v[jj].z * v[jj].z + v[jj].w * v[jj].w); }
                const float r = 1.0f / sqrtf(wave_sum(s) * (1.0f / DM) + EPS);
#pragma unroll
                for (int jj = 0; jj < 4; ++jj) { const f32x4 gg = *(const f32x4*)(PIN(19) + 4 * lane + 256 * jj); *(f32x4*)(xr + 256 * jj) = (v[jj] * r) * gg; }
            }
        }
        if (ph + 1 < ph_hi) grid.sync();
    }
}

extern "C" void kernel_launch(void* const* d_in, const int* in_sizes, int n_in, void* d_out, int out_size, void* d_ws, size_t ws_size, hipStream_t stream) {
    static int grid = 0;
    if (grid == 0) {
        if (n_in != 20 || in_sizes[0] != T * DM || out_size != T * DM || ws_size < WS_END) { fprintf(stderr, "kernel_launch: unexpected shapes (n_in %d, in0 %d, out %d, ws %zu)\n", n_in, n_in > 0 ? in_sizes[0] : -1, out_size, ws_size); grid = -1; return; }
        int dev = 0, cus = 0, per_cu = 0;
        (void)hipGetDevice(&dev); (void)hipDeviceGetAttribute(&cus, hipDeviceAttributeMultiprocessorCount, dev);
        if (hipFuncSetAttribute((const void*)fwd_megakernel, hipFuncAttributeMaxDynamicSharedMemorySize, LDS_BYTES) != hipSuccess) { fprintf(stderr, "kernel_launch: hipFuncSetAttribute failed\n"); grid = -1; return; }
        if (hipOccupancyMaxActiveBlocksPerMultiprocessor(&per_cu, (const void*)fwd_megakernel, 512, LDS_BYTES) != hipSuccess || per_cu < 1) { fprintf(stderr, "kernel_launch: occupancy query says %d\n", per_cu); per_cu = 1; }
        (void)hipGetLastError();
        if (cus <= 0) cus = 256;
        grid = cus;
    }
    if (grid < 0) return;
    Params p{};
    for (int i = 0; i < 20; ++i) p.in[i] = (const float*)d_in[i];
    p.out = (float*)d_out; p.ws = (unsigned char*)d_ws;
#if MK_ONE_LAUNCH
    p.ph_lo = 0; p.ph_hi = NPH;
    void* args[] = {&p};
    hipError_t e = hipLaunchCooperativeKernel((const void*)fwd_megakernel, dim3(grid), dim3(512), args, LDS_BYTES, stream);
    if (e != hipSuccess) fprintf(stderr, "kernel_launch: cooperative launch failed: %s (grid %d)\n", hipGetErrorString(e), grid);
#else
    for (int ph = 0; ph < NPH; ++ph) { p.ph_lo = ph; p.ph_hi = ph + 1; hipLaunchKernelGGL(fwd_megakernel, dim3(grid), dim3(512), LDS_BYTES, stream, p); }
#endif
}
```

```cpp
#include <hip/hip_runtime.h>
#include <hip/hip_cooperative_groups.h>
#include <cstdio>
#include <cstdint>
#include <cmath>
namespace cg = cooperative_groups;
#ifndef MK_ONE_LAUNCH
#define MK_ONE_LAUNCH 1
#endif
namespace pg8 {
#define PG8_LAS __attribute__((address_space(3)))
typedef unsigned short bf16_t;
typedef short bf16x8 __attribute__((ext_vector_type(8)));
typedef float f32x4 __attribute__((ext_vector_type(4)));
typedef unsigned u32x4 __attribute__((ext_vector_type(4)));
constexpr int BM = 256, BK = 64, HALF = 128, HTB = HALF * BK * 2  , STAGE_BYTES = 8 * HTB, NXCD = 8, WGM = 8;

__host__ __device__ __forceinline__ int lds_byte(int r, int c) { const int st = (r >> 4) * 2 + (c >> 5), rr = r & 15, cc = c & 31, ob = rr * 64 + cc * 2; return st * 1024 + (ob ^ (((ob >> 9) & 1) << 5)); }
__host__ __device__ __forceinline__ void stage_rc(int b, int& R, int& C) { const int st = b / 1024, sb = b % 1024, swz = sb ^ (((sb >> 9) & 1) << 5); R = (st >> 1) * 16 + swz / 64; C = (st & 1) * 32 + (swz % 64) / 2; }
__host__ __device__ __forceinline__ int perm32(int rho) { const int n = rho >> 4, i = rho & 15; return 8 * (i >> 2) + 4 * n + (i & 3); }

struct Unit { int pm, pn; };
struct Gemm { const bf16_t* A; const bf16_t* Bt; int M, N, K; };

struct StaticOrder {
    int nM, nN, nwg, G, c;
    __host__ __device__ void init(int M, int N, int G_, int c_) { nM = M / BM; nN = N / BM; nwg = nM * nN; G = G_; c = c_; }
    __host__ __device__ bool next(int i, Unit& u) const {
        const long L = (long)i * G + c; if (L >= nwg) return false;
        int wgid = (int)L; { const int q = nwg / NXCD, r = nwg % NXCD, xcd = wgid % NXCD, off = wgid / NXCD; wgid = (xcd < r ? xcd * (q + 1) : r * (q + 1) + (xcd - r) * q) + off; }
        const int nig = WGM * nN, gid = wgid / nig, fm = gid * WGM, gsz = (nM - fm) < WGM ? (nM - fm) : WGM;
        u.pm = fm + ((wgid % nig) % gsz); u.pn = (wgid % nig) / gsz; return true;
    }
    __device__ __forceinline__ void a_ready(const Unit&) const {}
    __device__ __forceinline__ void done(const Unit&) const {}
};

__device__ __forceinline__ unsigned cvt_pk_bf16(float lo, float hi) { unsigned r; asm volatile("v_cvt_pk_bf16_f32 %0, %1, %2" : "=v"(r) : "v"(lo), "v"(hi)); return r; }
typedef float f32x2 __attribute__((ext_vector_type(2)));
__device__ __forceinline__ f32x2 gelu_pk(f32x2 v) {
    const f32x2 av = __builtin_elementwise_abs(v), d = av * 0.2316418882f + 1.0f;
    f32x2 t; t.x = __builtin_amdgcn_rcpf(d.x); t.y = __builtin_amdgcn_rcpf(d.y);
    f32x2 q = t * 0.5307027145f + (-0.7265760135f); q = q * t + 0.7107068705f; q = q * t + (-0.142248368f); q = q * t + 0.127414796f; q = q * t;
    const f32x2 s = (v * v) * (-0.72134752044f);
    f32x2 e; e.x = __builtin_amdgcn_exp2f(s.x); e.y = __builtin_amdgcn_exp2f(s.y);
    const f32x2 m = v * (q * e), r = v - m;
    f32x2 o; o.x = v.x < 0.f ? m.x : r.x; o.y = v.y < 0.f ? m.y : r.y; return o;
}

template <int ACT  > struct EpiBf16 {
    static constexpr bool PERM = true, AFTER_DRAIN = false; static_assert(ACT == 0 || ACT == 1, "EpiBf16: ACT is 0 (none) or 1 (gelu_pk)");
    bf16_t* O; int ldc; const float* bias; int split_cols; size_t split_stride; float scale0;
    __device__ __forceinline__ void operator()(const f32x4 (&acc)[2][2][4][2], const Unit& u, int wr, int wc, int fr, int fq) const {
        const int row0 = u.pm * BM + wr * 64 + fr; int colt = u.pn * BM; bf16_t* base = O;
        float sc = 1.f; if (split_cols) { const int t = colt / split_cols; base += (size_t)t * split_stride; colt -= t * split_cols; if (t == 0) sc = scale0; }
        const int col0 = colt + wc * 32 + 8 * fq, bcol0 = u.pn * BM + wc * 32 + 8 * fq;
        f32x4 bv[2][2];
#pragma unroll
        for (int bj = 0; bj < 2; ++bj)
#pragma unroll
            for (int n = 0; n < 2; ++n) bv[bj][n] = bias ? *(const f32x4*)(bias + bcol0 + bj * HALF + 4 * n) : (f32x4){0.f, 0.f, 0.f, 0.f};
#pragma unroll
        for (int ai = 0; ai < 2; ++ai)
#pragma unroll
            for (int m = 0; m < 4; ++m) { bf16_t* rowp = base + (size_t)(row0 + ai * HALF + m * 16) * ldc + col0;
#pragma unroll
                for (int bj = 0; bj < 2; ++bj) { f32x4 v0 = acc[ai][bj][m][0] + bv[bj][0], v1 = acc[ai][bj][m][1] + bv[bj][1];
                    if (ACT == 1) { f32x2 a = gelu_pk((f32x2){v0[0], v0[1]}), b = gelu_pk((f32x2){v0[2], v0[3]}), c = gelu_pk((f32x2){v1[0], v1[1]}), d = gelu_pk((f32x2){v1[2], v1[3]});
                        v0 = (f32x4){a.x, a.y, b.x, b.y}; v1 = (f32x4){c.x, c.y, d.x, d.y}; }
                    v0 = v0 * sc; v1 = v1 * sc; u32x4 w; w.x = cvt_pk_bf16(v0[0], v0[1]); w.y = cvt_pk_bf16(v0[2], v0[3]); w.z = cvt_pk_bf16(v1[0], v1[1]); w.w = cvt_pk_bf16(v1[2], v1[3]);
                    *(u32x4*)(rowp + bj * HALF) = w; } }
    }
};

struct PanelStats {
    unsigned* xbuf;
    unsigned* cnt;
    unsigned* tmo;
    int ntn; float eps;
    unsigned code;
    __device__ __forceinline__ bool run(const f32x4 (&v)[2][2][4][2], const Unit& u, int wr, int wc, int fr, int fq, PG8_LAS unsigned char* lds, int wid, int lane) const {
        typedef float f32x2v __attribute__((ext_vector_type(2)));
        PG8_LAS f32x2v* P = (PG8_LAS f32x2v*)lds;
        PG8_LAS f32x2v* S = (PG8_LAS f32x2v*)(lds + 8192);
        PG8_LAS unsigned* flag = (PG8_LAS unsigned*)(lds + 8192 + 2048);
#pragma unroll
        for (int ai = 0; ai < 2; ++ai)
#pragma unroll
            for (int m = 0; m < 4; ++m) {
                float s = 0.f;
#pragma unroll
                for (int bj = 0; bj < 2; ++bj)
#pragma unroll
                    for (int n = 0; n < 2; ++n) { const f32x4 x = v[ai][bj][m][n]; s += (x[0] + x[1]) + (x[2] + x[3]); }
                s += __shfl_xor(s, 16); s += __shfl_xor(s, 32);
                const float mw = s * (1.0f / 64.0f); float q = 0.f;
#pragma unroll
                for (int bj = 0; bj < 2; ++bj)
#pragma unroll
                    for (int n = 0; n < 2; ++n) { const f32x4 d = v[ai][bj][m][n] - mw; q += (d[0] * d[0] + d[1] * d[1]) + (d[2] * d[2] + d[3] * d[3]); }
                q += __shfl_xor(q, 16); q += __shfl_xor(q, 32);
                if (fq == 0) P[(ai * HALF + wr * 64 + m * 16 + fr) * 4 + wc] = (f32x2v){mw, q};
            }
        asm volatile("s_waitcnt lgkmcnt(0)" ::: "memory"); __builtin_amdgcn_s_barrier(); asm volatile("" ::: "memory");
#if defined(BROKEN_EXCHANGE_NO_WAIT)
#warning BROKEN CONTROL BUILD: the row-statistics exchange does not wait; results are wrong by design
        if (blockIdx.x >= 64) { const long long t0_ = clock64(); while (clock64() - t0_ < 60000) __builtin_amdgcn_s_sleep(8); }
#endif
        const int row = wid * 32 + (lane & 31);
        if (lane < 32) {
            const f32x2v a = P[row * 4 + 0], b = P[row * 4 + 1], c = P[row * 4 + 2], d = P[row * 4 + 3];
            const float mt = (a.x + b.x + c.x + d.x) * 0.25f;
            const float da = a.x - mt, db = b.x - mt, dc = c.x - mt, dd = d.x - mt;
            const float m2 = (a.y + b.y) + (c.y + d.y) + 64.0f * ((da * da + db * db) + (dc * dc + dd * dd));
            unsigned long long* slot = (unsigned long long*)xbuf + ((size_t)(u.pm * BM + row) * 4 + u.pn);
            __hip_atomic_store(slot, ((unsigned long long)__float_as_uint(m2) << 32) | __float_as_uint(mt), __ATOMIC_RELAXED, __HIP_MEMORY_SCOPE_AGENT);
        }
        asm volatile("s_waitcnt vmcnt(0)" ::: "memory");
        if (lane == 0) __hip_atomic_fetch_add(cnt + 64 * u.pm, 1u, __ATOMIC_RELAXED, __HIP_MEMORY_SCOPE_AGENT);
        if (wid == 0) {
            bool dead = false; const unsigned long long t0 = __builtin_amdgcn_s_memrealtime(); const unsigned want = 8u * (unsigned)ntn;
            for (;;) {
#if defined(BROKEN_EXCHANGE_NO_WAIT)
                break;
#endif
                if ((unsigned)__builtin_amdgcn_readfirstlane(__hip_atomic_load(cnt + 64 * u.pm, __ATOMIC_RELAXED, __HIP_MEMORY_SCOPE_AGENT)) >= want) break;
                if (__builtin_amdgcn_s_memrealtime() - t0 > 2000000ull) {
                    if (lane == 0) { unsigned expect = 0u; __hip_atomic_compare_exchange_strong(tmo + 1, &expect, code | (unsigned)(u.pm & 0xff), __ATOMIC_RELAXED, __ATOMIC_RELAXED, __HIP_MEMORY_SCOPE_AGENT);
                                     __hip_atomic_store(tmo, 1u, __ATOMIC_RELAXED, __HIP_MEMORY_SCOPE_AGENT); }
                    dead = true; break; }
                __builtin_amdgcn_s_sleep(2);
            }
            __builtin_amdgcn_fence(__ATOMIC_ACQUIRE, "agent");
            if (lane == 0) flag[0] = dead ? 1u : 0u;
        }
        asm volatile("s_waitcnt vmcnt(0) lgkmcnt(0)" ::: "memory"); __builtin_amdgcn_s_barrier(); asm volatile("" ::: "memory");
        const bool bad = flag[0] != 0u;
        if (lane < 32) {
            const unsigned long long* slot = (const unsigned long long*)xbuf + (size_t)(u.pm * BM + row) * 4; float mt[4], m2[4]; float ms = 0.f;
#pragma unroll
            for (int t = 0; t < 4; ++t) { if (t < ntn) { const unsigned long long w = __hip_atomic_load(slot + t, __ATOMIC_RELAXED, __HIP_MEMORY_SCOPE_AGENT); mt[t] = __uint_as_float((unsigned)w); m2[t] = __uint_as_float((unsigned)(w >> 32)); } else { mt[t] = 0.f; m2[t] = 0.f; } ms += mt[t]; }
            const float mean = ms / (float)ntn; float q = 0.f;
#pragma unroll
            for (int t = 0; t < 4; ++t) if (t < ntn) { const float dm = mt[t] - mean; q += m2[t] + 256.0f * dm * dm; }
            S[row] = (f32x2v){mean, 1.0f / sqrtf(q / (256.0f * (float)ntn) + eps)};
        }
        asm volatile("s_waitcnt lgkmcnt(0)" ::: "memory"); __builtin_amdgcn_s_barrier(); asm volatile("" ::: "memory");
        return bad;
    }
};
struct EpiLnRes {
    static constexpr bool PERM = false, AFTER_DRAIN = true;
    const float* base; float* out; int ldc; const float* bias; PanelStats st; unsigned poison;
    __device__ __forceinline__ void fused(f32x4 (&acc)[2][2][4][2], const Unit& u, int wr, int wc, int fr, int fq, PG8_LAS unsigned char* lds, int wid, int lane) const {
        typedef float f32x2v __attribute__((ext_vector_type(2)));
        const PG8_LAS f32x2v* S = (const PG8_LAS f32x2v*)(lds + 8192);
        const int col0 = u.pn * BM + wc * 32 + 4 * fq;
#pragma unroll
        for (int bj = 0; bj < 2; ++bj)
#pragma unroll
            for (int n = 0; n < 2; ++n) { const f32x4 bv = bias ? *(const f32x4*)(bias + col0 + bj * HALF + n * 16) : (f32x4){0.f, 0.f, 0.f, 0.f};
#pragma unroll
                for (int ai = 0; ai < 2; ++ai)
#pragma unroll
                    for (int m = 0; m < 4; ++m) acc[ai][bj][m][n] += bv; }
        f32x4 pre[4][2][2];
#pragma unroll
        for (int m = 0; m < 4; ++m) { const size_t off = (size_t)(u.pm * BM + wr * 64 + m * 16 + fr) * ldc + col0;
#pragma unroll
            for (int bj = 0; bj < 2; ++bj)
#pragma unroll
                for (int n = 0; n < 2; ++n) pre[m][bj][n] = *(const f32x4*)(base + off + bj * HALF + n * 16); }
        const bool bad = st.run(acc, u, wr, wc, fr, fq, lds, wid, lane) || poison != 0u;
        const float qnan = __builtin_nanf("");
#pragma unroll
        for (int ai = 0; ai < 2; ++ai)
#pragma unroll
            for (int m = 0; m < 4; ++m) { const int r = ai * HALF + wr * 64 + m * 16 + fr; const f32x2v sr = S[r]; const size_t off = (size_t)(u.pm * BM + r) * ldc + col0;
#pragma unroll
                for (int bj = 0; bj < 2; ++bj)
#pragma unroll
                    for (int n = 0; n < 2; ++n) { const f32x4 bs = ai == 0 ? pre[m][bj][n] : *(const f32x4*)(base + off + bj * HALF + n * 16); f32x4 o = bs + (acc[ai][bj][m][n] - sr.x) * sr.y;
                        if (bad) o = (f32x4){qnan, qnan, qnan, qnan}; *(f32x4*)(out + off + bj * HALF + n * 16) = o; }
                if (m & 1) asm volatile("" ::: "memory"); }
    }
};
struct EpiLnResLn {
    static constexpr bool PERM = false, AFTER_DRAIN = true;
    const float* base; float* out; bf16_t* xn; int ldc; const float* bias; PanelStats st1, st2; unsigned poison;
    __device__ __forceinline__ void fused(f32x4 (&acc)[2][2][4][2], const Unit& u, int wr, int wc, int fr, int fq, PG8_LAS unsigned char* lds, int wid, int lane) const {
        typedef float f32x2v __attribute__((ext_vector_type(2))); typedef unsigned u32x2v __attribute__((ext_vector_type(2)));
        const PG8_LAS f32x2v* S = (const PG8_LAS f32x2v*)(lds + 8192);
        const int col0 = u.pn * BM + wc * 32 + 4 * fq;
#pragma unroll
        for (int bj = 0; bj < 2; ++bj)
#pragma unroll
            for (int n = 0; n < 2; ++n) { const f32x4 bv = bias ? *(const f32x4*)(bias + col0 + bj * HALF + n * 16) : (f32x4){0.f, 0.f, 0.f, 0.f};
#pragma unroll
                for (int ai = 0; ai < 2; ++ai)
#pragma unroll
                    for (int m = 0; m < 4; ++m) acc[ai][bj][m][n] += bv; }
        bool bad = st1.run(acc, u, wr, wc, fr, fq, lds, wid, lane) || poison != 0u;
        const float qnan = __builtin_nanf("");
#pragma unroll
        for (int ai = 0; ai < 2; ++ai)
#pragma unroll
            for (int m = 0; m < 4; ++m) { const int r = ai * HALF + wr * 64 + m * 16 + fr; const f32x2v sr = S[r]; const size_t off = (size_t)(u.pm * BM + r) * ldc + col0;
#pragma unroll
                for (int bj = 0; bj < 2; ++bj)
#pragma unroll
                    for (int n = 0; n < 2; ++n) { const f32x4 bs = *(const f32x4*)(base + off + bj * HALF + n * 16); acc[ai][bj][m][n] = bs + (acc[ai][bj][m][n] - sr.x) * sr.y; }
                asm volatile("" : "+v"(acc[ai][0][m][0]), "+v"(acc[ai][0][m][1]), "+v"(acc[ai][1][m][0]), "+v"(acc[ai][1][m][1]));
                if (m & 1) asm volatile("" ::: "memory"); }
        const bool bad1 = bad;
        bad = st2.run(acc, u, wr, wc, fr, fq, lds, wid, lane) || bad;
#pragma unroll
        for (int ai = 0; ai < 2; ++ai)
#pragma unroll
            for (int m = 0; m < 4; ++m) { const int r = ai * HALF + wr * 64 + m * 16 + fr; const f32x2v sr = S[r]; const size_t off = (size_t)(u.pm * BM + r) * ldc + col0;
#pragma unroll
                for (int bj = 0; bj < 2; ++bj)
#pragma unroll
                    for (int n = 0; n < 2; ++n) { const f32x4 x1 = acc[ai][bj][m][n]; *(f32x4*)(out + off + bj * HALF + n * 16) = bad1 ? (f32x4){qnan, qnan, qnan, qnan} : x1;
                        const f32x4 o = (x1 - sr.x) * sr.y; u32x2v w; w.x = cvt_pk_bf16(o[0], o[1]); w.y = cvt_pk_bf16(o[2], o[3]);
                        if (bad) { w.x = 0x7fc07fc0u; w.y = 0x7fc07fc0u; } *(u32x2v*)(xn + off + bj * HALF + n * 16) = w; }
                asm volatile("" ::: "memory"); }
    }
};

template <class Epi, class Sched, bool ALIGN_EPI = false, bool SP2 = false>
__device__ __forceinline__ void gemm_phase(PG8_LAS unsigned char* lds, const Gemm g, const Sched& S, const Epi& E) {
    int tid_ = threadIdx.x; asm volatile("" : "+v"(tid_));
    const int tid = tid_, wid = __builtin_amdgcn_readfirstlane(tid >> 6), lane = tid & 63, wr = wid >> 2, wc = wid & 3, fr = lane & 15, fq = lane >> 4;
    const int K = g.K, nt = K / BK;
    unsigned voffA[2], voffB[2];
#pragma unroll
    for (int i = 0; i < 2; ++i) { int R, C; stage_rc(tid * 16 + i * 8192, R, C); const int Rb = Epi::PERM ? ((R & ~31) + perm32(R & 31)) : R;
        voffA[i] = (unsigned)(R * K + C) * 2u; voffB[i] = (unsigned)(Rb * K + C) * 2u; }
    const size_t kstep = (size_t)(BK * 2);
    const size_t hstep = (size_t)HALF * K * 2;
    const size_t tstep = 2 * hstep;
    const unsigned ldsw = (unsigned)wid * 1024u;
    const int aoff = lds_byte(wr * 64 + fr, fq * 8), boff = lds_byte(wc * 32 + fr, fq * 8);
#define PG8_SA(b, h) (((b) * 2 + (h)) * HTB)
#define PG8_SB(b, h) ((4 + (b) * 2 + (h)) * HTB)
#define PG8_STAGE(bufoff, gbase, voff) do { _Pragma("unroll") for (int _i = 0; _i < 2; ++_i) \
        __builtin_amdgcn_global_load_lds((const unsigned*)((const char*)(gbase) + (voff)[_i]), (PG8_LAS unsigned*)(lds + (bufoff) + ldsw + _i * 8192), 16, 0, 0); } while (0)
#define PG8_LDA(dst, b, h) do { _Pragma("unroll") for (int m = 0; m < 4; ++m) _Pragma("unroll") for (int k = 0; k < 2; ++k) dst[m][k] = *(const PG8_LAS bf16x8*)(lds + PG8_SA(b, h) + aoff + m * 2048 + k * 1024); } while (0)
#define PG8_LDB(dst, b, h) do { _Pragma("unroll") for (int n = 0; n < 2; ++n) _Pragma("unroll") for (int k = 0; k < 2; ++k) dst[n][k] = *(const PG8_LAS bf16x8*)(lds + PG8_SB(b, h) + boff + n * 2048 + k * 1024); } while (0)
#define PG8_MMA(ai, bj, At, Bt) do { __builtin_amdgcn_s_setprio(1); _Pragma("unroll") for (int m = 0; m < 4; ++m) _Pragma("unroll") for (int n = 0; n < 2; ++n) _Pragma("unroll") for (int k = 0; k < 2; ++k) \
        acc[ai][bj][m][n] = __builtin_amdgcn_mfma_f32_16x16x32_bf16(Bt[n][k], At[m][k], acc[ai][bj][m][n], 0, 0, 0); __builtin_amdgcn_s_setprio(0); } while (0)
#define PG8_WAIT_V(n) asm volatile("s_waitcnt vmcnt(" #n ")" ::: "memory")
#define PG8_WAIT_L(n) asm volatile("s_waitcnt lgkmcnt(" #n ")" ::: "memory")
#define PG8_BAR __builtin_amdgcn_s_barrier()
#define PG8_SCHED __builtin_amdgcn_sched_barrier(0)
    Unit cur, nxt; int ui = 0;
    if (!S.next(0, cur)) return;
    f32x4 acc[2][2][4][2];
#pragma unroll
    for (int a = 0; a < 2; ++a)
#pragma unroll
        for (int b = 0; b < 2; ++b)
#pragma unroll
            for (int m = 0; m < 4; ++m)
#pragma unroll
                for (int n = 0; n < 2; ++n) acc[a][b][m][n] = (f32x4){0.f, 0.f, 0.f, 0.f};
    bf16x8 At[4][2], B0[2][2], B1[2][2];
    const char* cA = (const char*)g.A + (size_t)cur.pm * tstep; const char* cB = (const char*)g.Bt + (size_t)cur.pn * tstep;
    S.a_ready(cur);
    if constexpr (SP2) {
        PG8_STAGE(PG8_SB(0, 0), cB, voffB); PG8_STAGE(PG8_SB(0, 1), cB + hstep, voffB); PG8_STAGE(PG8_SA(0, 0), cA, voffA); PG8_STAGE(PG8_SA(0, 1), cA + hstep, voffA);
        if (wr == 1) PG8_BAR;
        PG8_WAIT_V(2); PG8_BAR;
        PG8_STAGE(PG8_SB(1, 0), cB + kstep, voffB); PG8_STAGE(PG8_SA(1, 0), cA + kstep, voffA); PG8_STAGE(PG8_SB(1, 1), cB + hstep + kstep, voffB);
        PG8_WAIT_V(6); PG8_BAR;
    } else {
        PG8_STAGE(PG8_SB(0, 0), cB, voffB); PG8_STAGE(PG8_SA(0, 0), cA, voffA); PG8_STAGE(PG8_SB(0, 1), cB + hstep, voffB); PG8_STAGE(PG8_SA(0, 1), cA + hstep, voffA);
        if (wr == 1) PG8_BAR;
        PG8_WAIT_V(4); PG8_BAR;
        PG8_STAGE(PG8_SB(1, 0), cB + kstep, voffB); PG8_STAGE(PG8_SA(1, 0), cA + kstep, voffA); PG8_STAGE(PG8_SB(1, 1), cB + hstep + kstep, voffB);
        PG8_WAIT_V(6); PG8_BAR;
    }
    for (;;) {
        const bool has_next = S.next(ui + 1, nxt);
        const char* nA = has_next ? (const char*)g.A + (size_t)nxt.pm * tstep : cA; const char* nB = has_next ? (const char*)g.Bt + (size_t)nxt.pn * tstep : cB;
        for (int t = 0; t < nt; t += 2) {
            const bool last = (t == nt - 2);
            const char* a1 = cA + (size_t)(t + 1) * kstep;
            const char* a2 = last ? nA : cA + (size_t)(t + 2) * kstep; const char* b2 = last ? nB : cB + (size_t)(t + 2) * kstep;
            const char* a3 = a2 + kstep; const char* b3 = b2 + kstep;
            if (last && has_next) S.a_ready(nxt);
            if constexpr (SP2) {
            PG8_LDB(B0, 0, 0); PG8_LDB(B1, 0, 1); PG8_SCHED; PG8_LDA(At, 0, 0); PG8_STAGE(PG8_SA(1, 1), a1 + hstep, voffA);
            PG8_WAIT_V(8); PG8_WAIT_L(0); PG8_BAR; PG8_MMA(0, 0, At, B0); PG8_MMA(0, 1, At, B1); PG8_BAR; PG8_SCHED;
            PG8_LDA(At, 0, 1); PG8_STAGE(PG8_SB(0, 0), b2, voffB); PG8_STAGE(PG8_SB(0, 1), b2 + hstep, voffB); PG8_STAGE(PG8_SA(0, 0), a2, voffA);
            PG8_WAIT_V(8); PG8_WAIT_L(0); PG8_BAR; PG8_MMA(1, 0, At, B0); PG8_MMA(1, 1, At, B1); PG8_BAR; PG8_SCHED;
            PG8_LDB(B0, 1, 0); PG8_LDB(B1, 1, 1); PG8_SCHED; PG8_LDA(At, 1, 0); PG8_STAGE(PG8_SA(0, 1), a2 + hstep, voffA);
            PG8_WAIT_V(8); PG8_WAIT_L(0); PG8_BAR; PG8_MMA(0, 0, At, B0); PG8_MMA(0, 1, At, B1); PG8_BAR; PG8_SCHED;
            PG8_LDA(At, 1, 1); PG8_STAGE(PG8_SB(1, 0), b3, voffB); PG8_STAGE(PG8_SB(1, 1), b3 + hstep, voffB); PG8_STAGE(PG8_SA(1, 0), a3, voffA);
            PG8_WAIT_V(8); PG8_WAIT_L(0); PG8_BAR; PG8_MMA(1, 0, At, B0); PG8_MMA(1, 1, At, B1); PG8_BAR; PG8_SCHED;
            } else {
            PG8_LDB(B0, 0, 0); PG8_SCHED; PG8_LDA(At, 0, 0); PG8_STAGE(PG8_SA(1, 1), a1 + hstep, voffA);
            PG8_WAIT_L(8); PG8_BAR; PG8_WAIT_L(0); PG8_MMA(0, 0, At, B0); PG8_BAR; PG8_SCHED;
            PG8_LDB(B1, 0, 1); PG8_STAGE(PG8_SB(0, 0), b2, voffB);
            PG8_BAR; PG8_WAIT_L(0); PG8_MMA(0, 1, At, B1); PG8_BAR;
            PG8_LDA(At, 0, 1); PG8_STAGE(PG8_SA(0, 0), a2, voffA);
            PG8_BAR; PG8_WAIT_L(0); PG8_MMA(1, 0, At, B0); PG8_BAR; PG8_SCHED;
            PG8_STAGE(PG8_SB(0, 1), b2 + hstep, voffB);
            PG8_WAIT_V(6); PG8_BAR; PG8_MMA(1, 1, At, B1); PG8_BAR;
            PG8_LDB(B0, 1, 0); PG8_SCHED; PG8_LDA(At, 1, 0); PG8_STAGE(PG8_SA(0, 1), a2 + hstep, voffA);
            PG8_WAIT_L(8); PG8_BAR; PG8_WAIT_L(0); PG8_MMA(0, 0, At, B0); PG8_BAR; PG8_SCHED;
            PG8_LDB(B1, 1, 1); PG8_STAGE(PG8_SB(1, 0), b3, voffB);
            PG8_BAR; PG8_WAIT_L(0); PG8_MMA(0, 1, At, B1); PG8_BAR;
            PG8_LDA(At, 1, 1); PG8_STAGE(PG8_SA(1, 0), a3, voffA);
            PG8_BAR; PG8_WAIT_L(0); PG8_MMA(1, 0, At, B0); PG8_BAR; PG8_SCHED;
            PG8_STAGE(PG8_SB(1, 1), b3 + hstep, voffB);
            PG8_WAIT_V(6); PG8_BAR; PG8_MMA(1, 1, At, B1); PG8_BAR;
            }
        }
        if constexpr (ALIGN_EPI) { if (wr == 0) PG8_BAR; }
        if constexpr (!Epi::AFTER_DRAIN) { E(acc, cur, wr, wc, fr, fq); S.done(cur); }
        if (!has_next) break;
#pragma unroll
        for (int a = 0; a < 2; ++a)
#pragma unroll
            for (int b = 0; b < 2; ++b)
#pragma unroll
                for (int m = 0; m < 4; ++m)
#pragma unroll
                    for (int n = 0; n < 2; ++n) acc[a][b][m][n] = (f32x4){0.f, 0.f, 0.f, 0.f};
        cur = nxt; cA = nA; cB = nB; ++ui;
        if constexpr (ALIGN_EPI) { if (wr == 1) PG8_BAR; }
    }
    PG8_WAIT_V(0);
    if constexpr (!ALIGN_EPI) { if (wr == 0) PG8_BAR; }
    PG8_BAR;
    if constexpr (Epi::AFTER_DRAIN) { E.fused(acc, cur, wr, wc, fr, fq, lds, wid, lane); S.done(cur); }
#undef PG8_SA
#undef PG8_SB
#undef PG8_STAGE
#undef PG8_LDA
#undef PG8_LDB
#undef PG8_MMA
#undef PG8_WAIT_V
#undef PG8_WAIT_L
#undef PG8_BAR
#undef PG8_SCHED
}
}
#define LAS __attribute__((address_space(3)))
#define DI_ __device__ __forceinline__
typedef unsigned short bf16_t;
typedef short bf16x8 __attribute__((ext_vector_type(8)));
typedef float f32x4 __attribute__((ext_vector_type(4)));
typedef float f32x2 __attribute__((ext_vector_type(2)));
typedef float f32x16 __attribute__((ext_vector_type(16)));
typedef unsigned u32x4 __attribute__((ext_vector_type(4)));
typedef unsigned u32x2 __attribute__((ext_vector_type(2)));
typedef __bf16 hbf2 __attribute__((ext_vector_type(2)));

constexpr int T = 16384, DM = 1024, DI = 2048, SEQ = 4096, NB = 4, NH = 16;
constexpr float EPS = 1e-6f;
constexpr float LOG2E = 1.4426950408889634f, LN2 = 0.6931471805599453f;
constexpr size_t MiB = 1u << 20;
constexpr size_t WS_WB = 1 * MiB, WS_H = 22 * MiB, WS_Q = 54 * MiB, WS_K = 118 * MiB, WS_VT = 182 * MiB, WS_CS = 246 * MiB, WS_LF = 250 * MiB, WS_CUM = 251 * MiB, WS_END = 252 * MiB;
constexpr size_t WS_O = WS_Q, WS_LAT = WS_Q, WS_QG = 118 * MiB  , WS_KL = 214 * MiB  , WS_KVNT = 220 * MiB  , WS_QN = 228 * MiB, WS_KVN = 236 * MiB;
constexpr size_t WB_IN = 0, WB_O = (size_t)8192 * 1024;
constexpr size_t WB1_LAT = 0, WB1_G = (size_t)448 * 1024  , WB1_Q = WB1_G + (size_t)2048 * 1024, WB1_K = WB1_Q + (size_t)3072 * 256, WB1_V = WB1_K + (size_t)2048 * 128, WB1_O = WB1_V + (size_t)2048 * 128;
constexpr int LDS_CTL_OFF = 147456, LDS_BYTES = LDS_CTL_OFF + 1024;
constexpr int NPH = 23;

DI_ unsigned pk2(float a, float b) { f32x2 v = {a, b}; hbf2 r = __builtin_convertvector(v, hbf2); return __builtin_bit_cast(unsigned, r); }
DI_ float bf_lo(unsigned u) { return __uint_as_float(u << 16); }
DI_ float bf_hi(unsigned u) { return __uint_as_float(u & 0xffff0000u); }
DI_ float wave_sum(float v) {
#pragma unroll
    for (int o = 1; o < 64; o <<= 1) v += __shfl_xor(v, o);
    return v;
}
DI_ float silu_f(float x) { return x * __builtin_amdgcn_rcpf(1.0f + __builtin_amdgcn_exp2f(-x * LOG2E)); }
#define LDS_WAIT() asm volatile("s_waitcnt lgkmcnt(0)" ::: "memory")

namespace pg8 {
struct EpiBf16K {
    static constexpr bool PERM = true, AFTER_DRAIN = false;
    bf16_t* O; int ldc; int split_cols; size_t split_stride; float* knp;
    __device__ __forceinline__ void operator()(const f32x4 (&acc)[2][2][4][2], const Unit& u, int wr, int wc, int fr, int fq) const {
        const int row0 = u.pm * BM + wr * 64 + fr; int colt = u.pn * BM; bf16_t* base = O; int t = 0;
        if (split_cols) { t = colt / split_cols; base += (size_t)t * split_stride; colt -= t * split_cols; }
        const int col0 = colt + wc * 32 + 8 * fq;
        const bool kn = knp != nullptr && t == 1;
#pragma unroll
        for (int ai = 0; ai < 2; ++ai)
#pragma unroll
            for (int m = 0; m < 4; ++m) { const int row = row0 + ai * HALF + m * 16; bf16_t* rowp = base + (size_t)row * ldc + col0;
#pragma unroll
                for (int bj = 0; bj < 2; ++bj) { const f32x4 v0 = acc[ai][bj][m][0], v1 = acc[ai][bj][m][1];
                    u32x4 w; w.x = ::pk2(v0[0], v0[1]); w.y = ::pk2(v0[2], v0[3]); w.z = ::pk2(v1[0], v1[1]); w.w = ::pk2(v1[2], v1[3]);
                    *(u32x4*)(rowp + bj * HALF) = w;
                    if (kn) { float ss = ((v0[0] * v0[0] + v0[1] * v0[1]) + (v0[2] * v0[2] + v0[3] * v0[3])) + ((v1[0] * v1[0] + v1[1] * v1[1]) + (v1[2] * v1[2] + v1[3] * v1[3]));
                        ss += __shfl_xor(ss, 16); ss += __shfl_xor(ss, 32);
                        if (fq == 0) knp[((size_t)((row >> 12) * 16 + (colt >> 7) + bj) * 4096 + (row & 4095)) * 4 + wc] = ss; } } }
    }
};
struct EpiGate {
    static constexpr bool PERM = true, AFTER_DRAIN = false;
    bf16_t* O; int ldc;
    __device__ __forceinline__ void operator()(const f32x4 (&acc)[2][2][4][2], const Unit& u, int wr, int wc, int fr, int fq) const {
        const int row0 = u.pm * BM + wr * 64 + fr, col0 = u.pn * BM + wc * 32 + 8 * fq;
#pragma unroll
        for (int ai = 0; ai < 2; ++ai)
#pragma unroll
            for (int m = 0; m < 4; ++m) { bf16_t* rowp = O + (size_t)(row0 + ai * HALF + m * 16) * ldc + col0;
#pragma unroll
                for (int bj = 0; bj < 2; ++bj) { const f32x4 v0 = acc[ai][bj][m][0], v1 = acc[ai][bj][m][1];
                    const u32x4 ov = *(const u32x4*)(rowp + bj * HALF); u32x4 w;
                    w.x = ::pk2(::bf_lo(ov.x) * ::silu_f(v0[0]), ::bf_hi(ov.x) * ::silu_f(v0[1]));
                    w.y = ::pk2(::bf_lo(ov.y) * ::silu_f(v0[2]), ::bf_hi(ov.y) * ::silu_f(v0[3]));
                    w.z = ::pk2(::bf_lo(ov.z) * ::silu_f(v1[0]), ::bf_hi(ov.z) * ::silu_f(v1[1]));
                    w.w = ::pk2(::bf_lo(ov.w) * ::silu_f(v1[2]), ::bf_hi(ov.w) * ::silu_f(v1[3]));
                    *(u32x4*)(rowp + bj * HALF) = w; } }
    }
};
template <bool HASBASE> struct EpiF32 {
    static constexpr bool PERM = false, AFTER_DRAIN = false;
    const float* base; float* out; int ldc;
    __device__ __forceinline__ void operator()(const f32x4 (&acc)[2][2][4][2], const Unit& u, int wr, int wc, int fr, int fq) const {
        const int row0 = u.pm * BM + wr * 64 + fr, col0 = u.pn * BM + wc * 32 + 4 * fq;
#pragma unroll
        for (int ai = 0; ai < 2; ++ai)
#pragma unroll
            for (int m = 0; m < 4; ++m) { const size_t off = (size_t)(row0 + ai * HALF + m * 16) * ldc + col0;
#pragma unroll
                for (int bj = 0; bj < 2; ++bj)
#pragma unroll
                    for (int n = 0; n < 2; ++n) { f32x4 v = acc[ai][bj][m][n]; if constexpr (HASBASE) v += *(const f32x4*)(base + off + bj * HALF + n * 16); *(f32x4*)(out + off + bj * HALF + n * 16) = v; } }
    }
};
}

DI_ void tr_item(const float* W, int ldw, int K, int k0, int col0, bf16_t* WT, int row0, LAS float* scr, int lane) {
#pragma unroll 8
    for (int i = 0; i < 32; ++i) { const int kk = 2 * i + (lane >> 5); scr[kk * 33 + (lane & 31)] = W[(size_t)(k0 + kk) * ldw + col0 + (lane & 31)]; }
    LDS_WAIT();
    const int c = lane & 7;
#pragma unroll
    for (int j = 0; j < 4; ++j) { const int n = (lane >> 3) + 8 * j; const LAS float* s = scr + (8 * c) * 33 + n;
        u32x4 o; o.x = pk2(s[0 * 33], s[1 * 33]); o.y = pk2(s[2 * 33], s[3 * 33]); o.z = pk2(s[4 * 33], s[5 * 33]); o.w = pk2(s[6 * 33], s[7 * 33]);
        *(u32x4*)(WT + (size_t)(row0 + n) * K + k0 + 8 * c) = o; }
    LDS_WAIT();
}
DI_ void conv_seg(const float* W, int ldw, int K, int col_start, int ncols, bf16_t* WT, int row_start, LAS float* scr, int gw, int NGW, int lane) {
    const int nblk = ncols / 32, nitems = (K / 64) * nblk;
    for (int it = gw; it < nitems; it += NGW) { const int kb = it / nblk, nb = it - kb * nblk; tr_item(W, ldw, K, 64 * kb, col_start + 32 * nb, WT, row_start + 32 * nb, scr, lane); }
}
#define XB_TMO      128
#define XB_XCNT(j)  (256  + 64 * (j))
#define XB_XSUB(j)  (1280 + 64 * (j))
#define XB_XGEN(j)  (2304 + 64 * (j))
#define XB_TOP      3328
#define XB_TOPGEN   3392
#define XCD_BAR_WORDS 3456
#define XB_SPIN_CAP (1u << 18)

__device__ __forceinline__ unsigned xb_ld(unsigned* p)              { return __hip_atomic_load(p, __ATOMIC_RELAXED, __HIP_MEMORY_SCOPE_AGENT); }
__device__ __forceinline__ unsigned xb_add(unsigned* p, unsigned v) { return __hip_atomic_fetch_add(p, v, __ATOMIC_RELAXED, __HIP_MEMORY_SCOPE_AGENT); }
__device__ __forceinline__ unsigned xb_xcc_id() { return (unsigned)__builtin_amdgcn_s_getreg((3 << 11) | 20) & 0xFu; }
#define XB_SPIN(cond, bar) do { unsigned _sp = 0; while (cond) { __builtin_amdgcn_s_sleep(1); \
    if ((++_sp & 255u) == 0u) { if (xb_ld(&(bar)[XB_TMO])) break; if (_sp > XB_SPIN_CAP) { atomicAdd(&(bar)[XB_TMO], 1u); break; } } } } while (0)

struct XcdBarrier {
    unsigned* bar; unsigned x;
    volatile LAS unsigned* st;
};

__device__ __forceinline__ XcdBarrier xcd_barrier_post(unsigned* bar, volatile LAS unsigned* st) {
    XcdBarrier b; b.bar = bar; b.x = xb_xcc_id(); b.st = st;
    if (threadIdx.x == 0) (void)xb_add(&bar[XB_XCNT(b.x)], 1u);
    return b;
}
__device__ __forceinline__ void xcd_barrier_complete(unsigned* bar, unsigned x, unsigned& nloc, unsigned& nx) {
    const unsigned G = gridDim.x * gridDim.y * gridDim.z;
    unsigned sum, cnt, mine, sp = 0u;
    for (;;) {
        sum = 0u; cnt = 0u; mine = 0u;
#pragma unroll
        for (unsigned j = 0; j < 16; ++j) { const unsigned c = xb_ld(&bar[XB_XCNT(j)]); sum += c; cnt += (c > 0u) ? 1u : 0u; mine = (j == x) ? c : mine; }
        if (sum == G) break;
        __builtin_amdgcn_s_sleep(1);
        if ((++sp & 255u) == 0u) { if (xb_ld(&bar[XB_TMO])) break; if (sp > XB_SPIN_CAP) { atomicAdd(&bar[XB_TMO], 1u); break; } }
    }
    nloc = mine > 0u ? mine : 1u; nx = cnt > 0u ? cnt : 1u;
}

__device__ __forceinline__ void xcd_barrier(const XcdBarrier& b) {
    asm volatile("s_waitcnt vmcnt(0)" ::: "memory");
    __syncthreads();
    if (threadIdx.x == 0) {
        unsigned* bar = b.bar;
        __builtin_amdgcn_s_waitcnt(0);
        unsigned nloc = b.st[0], nx = b.st[1];
        if (nloc == 0u) { xcd_barrier_complete(bar, b.x, nloc, nx); b.st[0] = nloc; b.st[1] = nx; }
        const unsigned old = xb_add(&bar[XB_XSUB(b.x)], 1u);
        const unsigned gen = old / nloc;
        if (old + 1u == (gen + 1u) * nloc) {
            __builtin_amdgcn_fence(__ATOMIC_RELEASE, "agent");
            asm volatile("s_waitcnt vmcnt(0)" ::: "memory");
            const unsigned og = xb_add(&bar[XB_TOP], 1u);
            const unsigned tg = og / nx;
            if (og + 1u == (tg + 1u) * nx) xb_add(&bar[XB_TOPGEN], 1u);
            else XB_SPIN(xb_ld(&bar[XB_TOPGEN]) == tg, bar);
            __builtin_amdgcn_fence(__ATOMIC_ACQUIRE, "agent");
            xb_add(&bar[XB_XGEN(b.x)], 1u);
            asm volatile("s_waitcnt vmcnt(0)" ::: "memory");
        } else {
            XB_SPIN(xb_ld(&bar[XB_XGEN(b.x)]) == gen, bar);
            __builtin_amdgcn_fence(__ATOMIC_ACQUIRE, "agent");
            asm volatile("s_waitcnt vmcnt(0)" ::: "memory");
        }
    }
    __syncthreads();
}
struct AttnP { const bf16_t* Q; const bf16_t* K; const bf16_t* KR; const bf16_t* VT; bf16_t* O; const float* cum; const float* cs; const float* kn2; const bf16_t* WV; int qpitch, kpitch, opitch, nh, khead, krpitch, vheadrows; };
#define MFMA32(a, b, c) __builtin_amdgcn_mfma_f32_32x32x16_bf16((a), (b), (c), 0, 0, 0)
DI_ bf16x8 pack8(float a0, float a1, float a2, float a3, float a4, float a5, float a6, float a7) {
    u32x4 w = {pk2(a0, a1), pk2(a2, a3), pk2(a4, a5), pk2(a6, a7)}; return __builtin_bit_cast(bf16x8, w);
}
DI_ float xhalf(float x) { return __shfl_xor(x, 32); }

DI_ void stick_half(f32x16& p, float& R, const bool diag, const int dqh, const int hi, const float C2) {
    float ls[16];
    if (diag) {
#pragma unroll
        for (int r = 0; r < 16; ++r) { const int kk = (r & 3) + 8 * (r >> 2) + 4 * hi; if (!(kk < dqh)) p[r] = -__builtin_inff(); }
    }
#pragma unroll
    for (int r = 0; r < 16; ++r) { const float z = __builtin_amdgcn_fmed3f(p[r] * C2, -150.f, 126.f), sp = __builtin_amdgcn_logf(1.0f + __builtin_amdgcn_exp2f(z)); ls[r] = -sp; p[r] = z - sp; }
    float gs[4], ps[4], tot[4];
#pragma unroll
    for (int g = 0; g < 4; ++g) { gs[g] = (ls[4 * g] + ls[4 * g + 1]) + (ls[4 * g + 2] + ls[4 * g + 3]); ps[g] = xhalf(gs[g]); tot[g] = gs[g] + ps[g]; }
    float suf = 0.f;
#pragma unroll
    for (int g = 3; g >= 0; --g) {
        const float l3 = R + suf + (hi == 0 ? ps[g] : 0.f), l2 = l3 + ls[4 * g + 3], l1 = l2 + ls[4 * g + 2], l0 = l1 + ls[4 * g + 1];
        p[4 * g + 3] = __builtin_amdgcn_exp2f(p[4 * g + 3] + l3); p[4 * g + 2] = __builtin_amdgcn_exp2f(p[4 * g + 2] + l2);
        p[4 * g + 1] = __builtin_amdgcn_exp2f(p[4 * g + 1] + l1); p[4 * g] = __builtin_amdgcn_exp2f(p[4 * g] + l0);
        suf += tot[g];
    }
    R += suf;
}

template <int MODE>
DI_ void attn_unit(LAS unsigned char* lds, const AttnP& P, const int b, const int hh, const int qb, bf16x8 (&qr)[(MODE == 1 ? 192 : 128) / 16], const bool q_loaded, const bool has_next, const int nb, const int nhh, const int nqb) {
    constexpr int DK = MODE == 1 ? 192 : 128, NKS = DK / 16, KROW = DK * 2, KT_BYTES = 64 * KROW, VSTR = 144, VT_BYTES = 128 * VSTR;
    constexpr int CT_OFF = KT_BYTES + VT_BYTES, BUF = CT_OFF + 256, FLAG_OFF = 2 * BUF;
    int tid_ = threadIdx.x; asm volatile("" : "+v"(tid_));
    const int tid = tid_, wid = __builtin_amdgcn_readfirstlane(tid >> 6), lane = tid & 63, r32 = lane & 31, hi = lane >> 5;
    const int q0 = qb * 256, tq = q0 + wid * 32 + r32;
    const size_t tokq = (size_t)b * SEQ + tq;
    constexpr float SCALE = MODE == 1 ? 0.07216878364870322f : 0.08838834764831845f;
    constexpr float C2 = SCALE * LOG2E;
    if (!q_loaded) { const bf16_t* qp = P.Q + tokq * P.qpitch + hh * DK + hi * 8;
#pragma unroll
      for (int d0 = 0; d0 < NKS; ++d0) qr[d0] = *(const bf16x8*)(qp + d0 * 16); }
    if constexpr (MODE == 1) {
#pragma unroll
        for (int dd = 0; dd < 2; ++dd) {
            const float* cp = P.cs + tokq * 32 + 16 * dd + 8 * hi; const float* sp = cp + (size_t)T * 32;
            const f32x4 c0 = *(const f32x4*)cp, c1 = *(const f32x4*)(cp + 4), s0 = *(const f32x4*)sp, s1 = *(const f32x4*)(sp + 4);
            const u32x4 a = __builtin_bit_cast(u32x4, qr[8 + dd]), bb = __builtin_bit_cast(u32x4, qr[10 + dd]);
            float x1[8] = {bf_lo(a.x), bf_hi(a.x), bf_lo(a.y), bf_hi(a.y), bf_lo(a.z), bf_hi(a.z), bf_lo(a.w), bf_hi(a.w)};
            float x2[8] = {bf_lo(bb.x), bf_hi(bb.x), bf_lo(bb.y), bf_hi(bb.y), bf_lo(bb.z), bf_hi(bb.z), bf_lo(bb.w), bf_hi(bb.w)};
            float cc[8] = {c0[0], c0[1], c0[2], c0[3], c1[0], c1[1], c1[2], c1[3]}, ss[8] = {s0[0], s0[1], s0[2], s0[3], s1[0], s1[1], s1[2], s1[3]};
            float y1[8], y2[8];
#pragma unroll
            for (int i = 0; i < 8; ++i) { y1[i] = x1[i] * cc[i] - x2[i] * ss[i]; y2[i] = x1[i] * ss[i] + x2[i] * cc[i]; }
            qr[8 + dd] = pack8(y1[0], y1[1], y1[2], y1[3], y1[4], y1[5], y1[6], y1[7]);
            qr[10 + dd] = pack8(y2[0], y2[1], y2[2], y2[3], y2[4], y2[5], y2[6], y2[7]);
        }
    }
    const bf16_t* Kg = P.K + (size_t)b * SEQ * P.kpitch + hh * P.khead;
    const bf16_t* VTg = P.VT + (size_t)(hh * P.vheadrows) * T + (size_t)b * SEQ;
    const int krow = tid >> 4, kc = tid & 15;
    const int ksw = MODE == 1 ? krow * KROW + ((kc ^ ((((krow >> 1) & 1) << 2) | ((krow >> 2) & 3))) << 4) : krow * KROW + ((kc ^ (krow & 15)) << 4);
    const int rrow = tid >> 3, rc = tid & 7;
    const int rsw = rrow * KROW + (((16 + rc) ^ ((((rrow >> 1) & 1) << 2) | ((rrow >> 2) & 3))) << 4);
    const int vrow = tid >> 3, vc = tid & 7;
    const int vsw = KT_BYTES + vrow * VSTR + (vc >> 1) * 32 + (vc & 1) * 8;
    const int kfb = MODE == 1 ? r32 * KROW : r32 * KROW + ((hi ^ (r32 & 15)) << 4);
    const int kg16 = (hi ^ ((((r32 >> 1) & 1) << 2) | ((r32 >> 2) & 3))) << 4;
    const int vfb = KT_BYTES + r32 * VSTR + hi * 16;
    float m_run = -1e30f, l_run = 0.f, R = 0.f;
    f32x16 o[4];
#pragma unroll
    for (int d = 0; d < 4; ++d)
#pragma unroll
        for (int r = 0; r < 16; ++r) o[d][r] = 0.f;
    const int jd = (q0 >> 6) + (wid >> 1), jtop = (q0 >> 6) + 3;
    const int dq = (wid & 1) * 32 + r32;
    constexpr bool DESC = MODE != 1;
    int j = DESC ? jtop : 0;
    bf16x8 sk0, sk1, skr, sv0, sv1; float scv = 0.f;
#define A_GLOAD(jj) do { const bf16_t* kp = Kg + (size_t)((jj) * 64 + krow) * P.kpitch + kc * 8; sk0 = *(const bf16x8*)kp; sk1 = *(const bf16x8*)(kp + (size_t)32 * P.kpitch); \
        if constexpr (MODE == 1) skr = *(const bf16x8*)(P.KR + ((size_t)b * SEQ + (jj) * 64 + rrow) * P.krpitch + rc * 8); \
        if constexpr (MODE != 1) { const bf16_t* vp = VTg + (size_t)vrow * T + (jj) * 64 + vc * 8; sv0 = *(const bf16x8*)vp; sv1 = *(const bf16x8*)(vp + (size_t)64 * T); } \
        if constexpr (MODE == 2) { if (tid < 64) scv = P.cum[((size_t)b * NH + hh) * SEQ + (jj) * 64 + tid]; } } while (0)
#define A_SWRITE(bufi) do { LAS unsigned char* bp = lds + (bufi) * BUF; *(LAS bf16x8*)(bp + ksw) = sk0; *(LAS bf16x8*)(bp + ksw + 32 * KROW) = sk1; \
        if constexpr (MODE == 1) *(LAS bf16x8*)(bp + rsw) = skr; \
        if constexpr (MODE != 1) { const u32x4 a = __builtin_bit_cast(u32x4, sv0), c = __builtin_bit_cast(u32x4, sv1); \
          *(LAS u32x2*)(bp + vsw) = (u32x2){a.x, a.y}; *(LAS u32x2*)(bp + vsw + 16) = (u32x2){a.z, a.w}; \
          *(LAS u32x2*)(bp + vsw + 64 * VSTR) = (u32x2){c.x, c.y}; *(LAS u32x2*)(bp + vsw + 64 * VSTR + 16) = (u32x2){c.z, c.w}; } \
        if constexpr (MODE == 2) { if (tid < 64) *(LAS float*)(bp + CT_OFF + tid * 4) = scv; } } while (0)
    float bound_t = 0.f;
    if constexpr (MODE != 0) {
        float km = 0.f;
        if constexpr (MODE == 2) { const f32x4* kn = (const f32x4*)P.kn2 + ((size_t)b * NH + hh) * SEQ;
            for (int i = tid; i < q0 + 256; i += 512) { const f32x4 v = kn[i]; km = fmaxf(km, (v.x + v.y) + (v.z + v.w)); } }
        else { const float* kn = P.kn2 + (size_t)b * SEQ;
            for (int i = tid; i < q0 + 256; i += 512) km = fmaxf(km, kn[i]); }
#pragma unroll
        for (int o_ = 1; o_ < 64; o_ <<= 1) km = fmaxf(km, __shfl_xor(km, o_));
        if (lane == 0) *(LAS float*)(lds + FLAG_OFF + 64 + wid * 4) = km;
        float q2 = 0.f;
#pragma unroll
        for (int d0 = 0; d0 < NKS; ++d0) { const u32x4 a = __builtin_bit_cast(u32x4, qr[d0]);
            q2 += (bf_lo(a.x) * bf_lo(a.x) + bf_hi(a.x) * bf_hi(a.x)) + (bf_lo(a.y) * bf_lo(a.y) + bf_hi(a.y) * bf_hi(a.y)) + (bf_lo(a.z) * bf_lo(a.z) + bf_hi(a.z) * bf_hi(a.z)) + (bf_lo(a.w) * bf_lo(a.w) + bf_hi(a.w) * bf_hi(a.w)); }
        q2 += xhalf(q2);
        bound_t = q2;
    }
    A_GLOAD(j); A_SWRITE(0);
    if (DESC ? (j > 0) : (j < jtop)) A_GLOAD(DESC ? j - 1 : j + 1);
    __syncthreads();
    if constexpr (MODE != 0) { const f32x4 k0 = *(const LAS f32x4*)(lds + FLAG_OFF + 64), k1 = *(const LAS f32x4*)(lds + FLAG_OFF + 80);
        const float km2 = fmaxf(fmaxf(fmaxf(k0.x, k0.y), fmaxf(k0.z, k0.w)), fmaxf(fmaxf(k1.x, k1.y), fmaxf(k1.z, k1.w)));
        bound_t = sqrtf(bound_t * km2) * (C2 * 1.02f); }
    float nck_t = 0.f;
    if constexpr (MODE == 2) nck_t = P.cum[((size_t)b * NH + hh) * SEQ + tq];
    bool wdone = false;
    for (int it = 0;; ++it) {
        const int cur = it & 1;
        const int jn = DESC ? j - 1 : j + 1;
        const bool pre = DESC ? (j > 0) : (j < jtop);
        const bool act = (j <= jd) && !wdone;
        if (act) {
            const LAS unsigned char* bp = lds + cur * BUF;
            f32x16 p0, p1;
#pragma unroll
            for (int r = 0; r < 16; ++r) { p0[r] = 0.f; p1[r] = 0.f; }
            {
                bf16x8 kf[3][2];
#define A_KLD(d0_) do { const int ka_ = MODE == 1 ? kfb + (((d0_) << 5) ^ kg16) : (kfb ^ ((d0_) << 5)); kf[(d0_) % 3][0] = *(const LAS bf16x8*)(bp + ka_); kf[(d0_) % 3][1] = *(const LAS bf16x8*)(bp + ka_ + 32 * KROW); } while (0)
                A_KLD(0); A_KLD(1);
#pragma unroll
                for (int d0 = 0; d0 < NKS; ++d0) {
                    if (d0 + 2 < NKS) A_KLD(d0 + 2);
                    p0 = MFMA32(kf[d0 % 3][0], qr[d0], p0); p1 = MFMA32(kf[d0 % 3][1], qr[d0], p1);
                }
#undef A_KLD
                __builtin_amdgcn_sched_group_barrier(0x100, 4, 0);
#pragma unroll
                for (int d0 = 0; d0 < NKS - 2; ++d0) { __builtin_amdgcn_sched_group_barrier(0x100, 2, 0); __builtin_amdgcn_sched_group_barrier(0x008, 2, 0); }
                __builtin_amdgcn_sched_group_barrier(0x008, 4, 0);
            }
            const bool diag = (j == jd);
            if constexpr (MODE == 0) {
                stick_half(p1, R, diag, dq - 32, hi, C2);
                __builtin_amdgcn_sched_barrier(0);
                stick_half(p0, R, diag, dq, hi, C2);
                wdone = __all(R < -46.0f) != 0;
            } else {
                if constexpr (MODE == 2) {
#pragma unroll
                    for (int g = 0; g < 4; ++g) {
                        const f32x4 ck0 = *(const LAS f32x4*)(bp + CT_OFF + g * 32 + hi * 16), ck1 = *(const LAS f32x4*)(bp + CT_OFF + 128 + g * 32 + hi * 16);
#pragma unroll
                        for (int e = 0; e < 4; ++e) { const int r = 4 * g + e, kk = 8 * g + 4 * hi + e;
                            float y0 = fmaf(p0[r], C2, ck0[e]), y1 = fmaf(p1[r], C2, ck1[e]);
                            if (diag) { if (kk > dq) y0 = -__builtin_inff(); if (kk + 32 > dq) y1 = -__builtin_inff(); }
                            p0[r] = y0; p1[r] = y1; }
                    }
                }
                if constexpr (MODE == 2) m_run = bound_t + nck_t;
                if constexpr (MODE != 0) {
                    if constexpr (MODE == 1) m_run = bound_t;
                } else {
                float pmax = fmaxf(p0[0], p1[0]);
#pragma unroll
                for (int r = 1; r < 16; ++r) pmax = fmaxf(pmax, fmaxf(p0[r], p1[r]));
                pmax = fmaxf(pmax, xhalf(pmax));
                if (!__all(pmax - m_run <= 8.0f)) {
                    const float mn = fmaxf(m_run, pmax), alpha = __builtin_amdgcn_exp2f(m_run - mn);
                    m_run = mn; l_run *= alpha;
#pragma unroll
                    for (int d = 0; d < 4; ++d)
#pragma unroll
                        for (int r = 0; r < 16; ++r) o[d][r] *= alpha;
                }
                }
                float ps0 = 0.f, ps1 = 0.f;
#pragma unroll
                for (int r = 0; r < 16; ++r) {
                    if constexpr (MODE == 1) { p0[r] = __builtin_amdgcn_exp2f(fmaf(p0[r], C2, -m_run)); p1[r] = __builtin_amdgcn_exp2f(fmaf(p1[r], C2, -m_run)); }
                    else { p0[r] = __builtin_amdgcn_exp2f(p0[r] - m_run); p1[r] = __builtin_amdgcn_exp2f(p1[r] - m_run); }
                    ps0 += p0[r]; ps1 += p1[r]; }
                l_run += ps0 + ps1;
                if constexpr (MODE == 2) {
                    const float nck0 = *(const LAS float*)(bp + CT_OFF);
                    wdone = __all((nck0 - nck_t) - __builtin_amdgcn_logf(l_run + xhalf(l_run)) < -56.0f) != 0;
                }
            }
            bf16x8 pb[4];
            pb[0] = pack8(p0[0], p0[1], p0[2], p0[3], p0[4], p0[5], p0[6], p0[7]); pb[1] = pack8(p0[8], p0[9], p0[10], p0[11], p0[12], p0[13], p0[14], p0[15]);
            pb[2] = pack8(p1[0], p1[1], p1[2], p1[3], p1[4], p1[5], p1[6], p1[7]); pb[3] = pack8(p1[8], p1[9], p1[10], p1[11], p1[12], p1[13], p1[14], p1[15]);
            {
                bf16x8 vf[5];
                typedef short s16x4_ __attribute__((ext_vector_type(4)));
                const int trq = (lane & 15) >> 2, trp = lane & 3, trg = (lane >> 4) & 1, trqh = trq >> 1;
                const int trl0 = (((2 * trg + (trp >> 1)) ^ hi) << 4) | ((trp & 1) * 8), trl1 = (((2 * trg + (trp >> 1)) ^ hi ^ 2) << 4) | ((trp & 1) * 8);
                const int trE = (4 * hi + trq) * KROW + trqh * 64, trO = (4 * hi + trq) * KROW - trqh * 64;
#define A_VLD_TR(i_) do { const int cb_ = (((i_) & 1) ? trO : trE) + ((i_) >> 2) * 16 * KROW + ((i_) & 3) * 64; \
                    const s16x4_ t0_ = __builtin_amdgcn_ds_read_tr16_b64_v4i16((LAS s16x4_*)(bp + cb_ + trl0)); \
                    const s16x4_ t1_ = __builtin_amdgcn_ds_read_tr16_b64_v4i16((LAS s16x4_*)(bp + cb_ + 8 * KROW + trl1)); \
                    vf[(i_) % 5] = (bf16x8){t0_[0], t0_[1], t0_[2], t0_[3], t1_[0], t1_[1], t1_[2], t1_[3]}; } while (0)
#define A_VLD(i_) do { if constexpr (MODE == 1) A_VLD_TR(i_); else vf[(i_) % 5] = *(const LAS bf16x8*)(bp + vfb + ((i_) & 3) * 32 * VSTR + ((i_) >> 2) * 32); } while (0)
                A_VLD(0); A_VLD(1); A_VLD(2); A_VLD(3);
#pragma unroll
                for (int i = 0; i < 16; ++i) {
                    if (i + 4 < 16) A_VLD(i + 4);
                    o[i & 3] = MFMA32(vf[i % 5], pb[i >> 2], o[i & 3]);
                }
#undef A_VLD
#undef A_VLD_TR
                constexpr int RPF = MODE == 1 ? 2 : 1;
                __builtin_amdgcn_sched_group_barrier(0x100, 4 * RPF, 1);
#pragma unroll
                for (int i = 0; i < 12; ++i) { __builtin_amdgcn_sched_group_barrier(0x100, RPF, 1); __builtin_amdgcn_sched_group_barrier(0x008, 1, 1); }
                __builtin_amdgcn_sched_group_barrier(0x008, 4, 1);
            }
        }
        if constexpr (DESC) { if (lane == 0) *(LAS unsigned*)(lds + FLAG_OFF + (cur * 8 + wid) * 4) = wdone ? 1u : 0u; }
        if (pre) { A_SWRITE(cur ^ 1);
            const int jn2 = DESC ? jn - 1 : jn + 1; if (DESC ? (jn > 0) : (jn < jtop)) A_GLOAD(jn2); }
        __syncthreads();
        bool alldone = false;
        if constexpr (DESC) { const u32x4 f0 = *(const LAS u32x4*)(lds + FLAG_OFF + cur * 32), f1 = *(const LAS u32x4*)(lds + FLAG_OFF + cur * 32 + 16);
            alldone = (f0.x & f0.y & f0.z & f0.w & f1.x & f1.y & f1.z & f1.w) != 0u; }
        if (!pre || alldone) break;
        j = jn;
    }
#undef A_GLOAD
#undef A_SWRITE
    if (has_next) { const bf16_t* qp = P.Q + ((size_t)nb * SEQ + nqb * 256 + wid * 32 + r32) * P.qpitch + nhh * DK + hi * 8;
#pragma unroll
      for (int d0 = 0; d0 < NKS; ++d0) qr[d0] = *(const bf16x8*)(qp + d0 * 16); }
    if constexpr (MODE != 0) { const float lt = l_run + xhalf(l_run), inv = 1.0f / lt;
#pragma unroll
        for (int d = 0; d < 4; ++d)
#pragma unroll
            for (int r = 0; r < 16; ++r) o[d][r] *= inv; }
    if constexpr (MODE == 1) {
        constexpr int WSTR = 272;
        { const bf16_t* wg = P.WV + (size_t)(hh * 128) * 128;
#pragma unroll
          for (int i = 0; i < 4; ++i) { const int id = tid + 512 * i, d = id >> 4, ch = id & 15; const u32x4 a = *(const u32x4*)(wg + (size_t)d * 128 + ch * 8);
              LAS unsigned char* wp = lds + d * WSTR + (ch >> 1) * 32 + (ch & 1) * 8; *(LAS u32x2*)wp = (u32x2){a.x, a.y}; *(LAS u32x2*)(wp + 16) = (u32x2){a.z, a.w}; } }
        bf16x8 ob[4][2];
#pragma unroll
        for (int cb = 0; cb < 4; ++cb) { ob[cb][0] = pack8(o[cb][0], o[cb][1], o[cb][2], o[cb][3], o[cb][4], o[cb][5], o[cb][6], o[cb][7]); ob[cb][1] = pack8(o[cb][8], o[cb][9], o[cb][10], o[cb][11], o[cb][12], o[cb][13], o[cb][14], o[cb][15]); }
        __syncthreads();
#pragma unroll
        for (int db = 0; db < 4; ++db) { f32x16 acc;
#pragma unroll
            for (int r = 0; r < 16; ++r) acc[r] = 0.f;
#pragma unroll
            for (int cb = 0; cb < 4; ++cb)
#pragma unroll
                for (int s = 0; s < 2; ++s) { const bf16x8 av = *(const LAS bf16x8*)(lds + (db * 32 + r32) * WSTR + (cb * 2 + s) * 32 + hi * 16); acc = MFMA32(av, ob[cb][s], acc); }
            o[db] = acc; }
        __syncthreads();
    }
    {
        constexpr int OSTR = 144, OST_OFF = 88 * 1024; static_assert(FLAG_OFF + 128 <= OST_OFF && OST_OFF + 8 * 32 * OSTR <= 131072, "O slab");
        LAS unsigned char* ob = lds + OST_OFF + wid * (32 * OSTR);
        bf16_t* og = P.O + ((size_t)b * SEQ + q0 + wid * 32) * P.opitch + hh * 128;
#pragma unroll
        for (int h = 0; h < 2; ++h) {
#pragma unroll
            for (int dd = 0; dd < 2; ++dd)
#pragma unroll
                for (int g = 0; g < 4; ++g) { const int d = 2 * h + dd;
                    *(LAS u32x2*)(ob + r32 * OSTR + (dd * 32 + 8 * g + 4 * hi) * 2) = (u32x2){pk2(o[d][4 * g], o[d][4 * g + 1]), pk2(o[d][4 * g + 2], o[d][4 * g + 3])}; }
            LDS_WAIT();
#pragma unroll
            for (int i = 0; i < 4; ++i) { const int row = 8 * i + (lane >> 3), ch = lane & 7;
                const u32x4 v = *(const LAS u32x4*)(ob + row * OSTR + ch * 16);
                *(u32x4*)(og + (size_t)row * P.opitch + h * 64 + ch * 8) = v; }
            LDS_WAIT();
        }
    }
}
DI_ void stick_wave_phase(LAS unsigned char* lds, const AttnP& P, const int gw, const int NGW) {
    constexpr int WSLAB = 18432, VOFF = 8192, VROW = 320;
    constexpr float C2 = 0.08838834764831845f * LOG2E;
    int tid_ = threadIdx.x; asm volatile("" : "+v"(tid_));
    const int wid = __builtin_amdgcn_readfirstlane(tid_ >> 6), lane = tid_ & 63, r32 = lane & 31, hi = lane >> 5;
    LAS unsigned char* wl = lds + wid * WSLAB;
    const int kfb = r32 * 256 + ((hi ^ (r32 & 15)) << 4);
    const int vfb = VOFF + (4 * hi + ((lane & 15) >> 2)) * VROW + ((lane >> 4) & 1) * 32 + (lane & 3) * 8;
#define SW_UNIT(w0_) ((NGW == 2048) ? (((16 * ((w0_) >> 11) + 2 * (((w0_) >> 3) & 7) + ((((w0_) >> 3 & 255) >> 3) >> 4)) << 7) + ((((w0_) >> 3 & 255) >> 3) & 15) * 8 + ((w0_) & 7)) : (w0_))
#define SW_QLOAD(wu_) do { const int bh_ = (wu_) >> 7, rb_ = (wu_) & 127; const bf16_t* qp = P.Q + ((size_t)(bh_ >> 4) * SEQ + 32 * rb_ + r32) * P.qpitch + (bh_ & 15) * 128 + hi * 8; \
        _Pragma("unroll") for (int d0 = 0; d0 < 8; ++d0) qn[d0] = *(const bf16x8*)(qp + d0 * 16); } while (0)
    bf16x8 qn[8];
    if (gw < NB * NH * 128) { const int wu_first = SW_UNIT(gw); SW_QLOAD(wu_first); }
    for (int wu0 = gw; wu0 < NB * NH * 128; wu0 += NGW) {
        const int wu = SW_UNIT(wu0);
        const int bh = wu >> 7, rb = wu & 127, b = bh >> 4, hh = bh & 15;
        bf16x8 qr[8];
#pragma unroll
        for (int d0 = 0; d0 < 8; ++d0) qr[d0] = qn[d0];
        const bf16_t* Kg = P.K + (size_t)b * SEQ * P.kpitch + hh * 128;
        const bf16_t* Vg = P.VT + (size_t)b * SEQ * P.kpitch + hh * 128;
        f32x16 o[4];
#pragma unroll
        for (int d = 0; d < 4; ++d)
#pragma unroll
            for (int r = 0; r < 16; ++r) o[d][r] = 0.f;
        float R = 0.f;
        for (int jt = rb; jt >= 0; --jt) {
            {
                bf16x8 ks[8], vs[8];
#pragma unroll
                for (int i = 0; i < 8; ++i) { const int id = lane + 64 * i; ks[i] = *(const bf16x8*)(Kg + (size_t)(jt * 32 + (id >> 4)) * P.kpitch + (id & 15) * 8); }
#pragma unroll
                for (int i = 0; i < 8; ++i) { const int id = lane + 64 * i; vs[i] = *(const bf16x8*)(Vg + (size_t)(jt * 32 + (id >> 4)) * P.kpitch + (id & 15) * 8); }
#pragma unroll
                for (int i = 0; i < 8; ++i) { const int id = lane + 64 * i, row = id >> 4, c = id & 15; *(LAS bf16x8*)(wl + row * 256 + ((c ^ (row & 15)) << 4)) = ks[i]; }
#pragma unroll
                for (int i = 0; i < 8; ++i) { const int id = lane + 64 * i; *(LAS bf16x8*)(wl + VOFF + (id >> 4) * VROW + (id & 15) * 16) = vs[i]; }
            }
            LDS_WAIT();
            f32x16 p;
#pragma unroll
            for (int r = 0; r < 16; ++r) p[r] = 0.f;
#pragma unroll
            for (int d0 = 0; d0 < 8; ++d0) { const bf16x8 kf = *(const LAS bf16x8*)(wl + (kfb ^ (d0 << 5))); p = MFMA32(kf, qr[d0], p); }
            stick_half(p, R, jt == rb, r32, hi, C2);
            const bf16x8 pb0 = pack8(p[0], p[1], p[2], p[3], p[4], p[5], p[6], p[7]), pb1 = pack8(p[8], p[9], p[10], p[11], p[12], p[13], p[14], p[15]);
#pragma unroll
            for (int i = 0; i < 8; ++i) {
                typedef short s16x4_ __attribute__((ext_vector_type(4)));
                const s16x4_ t0 = __builtin_amdgcn_ds_read_tr16_b64_v4i16((LAS s16x4_*)(wl + vfb + (i >> 2) * 16 * VROW + (i & 3) * 64));
                const s16x4_ t1 = __builtin_amdgcn_ds_read_tr16_b64_v4i16((LAS s16x4_*)(wl + vfb + (i >> 2) * 16 * VROW + 8 * VROW + (i & 3) * 64));
                const bf16x8 vf = {t0[0], t0[1], t0[2], t0[3], t1[0], t1[1], t1[2], t1[3]};
                o[i & 3] = MFMA32(vf, (i >> 2) ? pb1 : pb0, o[i & 3]); }
            LDS_WAIT();
            if (__all(R < -46.0f)) break;
        }
        if (wu0 + NGW < NB * NH * 128) { const int wu_next = SW_UNIT(wu0 + NGW); SW_QLOAD(wu_next); }
        {
            constexpr int OSTR = 144;
            bf16_t* og = P.O + ((size_t)b * SEQ + 32 * rb) * P.opitch + hh * 128;
#pragma unroll
            for (int h = 0; h < 2; ++h) {
#pragma unroll
                for (int dd = 0; dd < 2; ++dd)
#pragma unroll
                    for (int g = 0; g < 4; ++g) { const int d = 2 * h + dd;
                        *(LAS u32x2*)(wl + r32 * OSTR + (dd * 32 + 8 * g + 4 * hi) * 2) = (u32x2){pk2(o[d][4 * g], o[d][4 * g + 1]), pk2(o[d][4 * g + 2], o[d][4 * g + 3])}; }
                LDS_WAIT();
#pragma unroll
                for (int i = 0; i < 4; ++i) { const int row = 8 * i + (lane >> 3), ch = lane & 7;
                    const u32x4 v = *(const LAS u32x4*)(wl + row * OSTR + ch * 16);
                    *(u32x4*)(og + (size_t)row * P.opitch + h * 64 + ch * 8) = v; }
                LDS_WAIT();
            }
        }
    }
#undef SW_UNIT
#undef SW_QLOAD
}

template <int MODE>
DI_ void attn_phase(LAS unsigned char* lds, const AttnP& P, int G, int bid) {
    if (__builtin_amdgcn_readfirstlane(threadIdx.x >> 6) >= 4) __builtin_amdgcn_s_setprio(1); else __builtin_amdgcn_s_setprio(0);
    if constexpr (MODE == 0) { const int total = 4 * P.nh * 16;
        bf16x8 qr0[8];
        for (int L = bid; L < total; L += G) { const int qb = (L >> 3) & 15, bh = (L & 7) + 8 * (L >> 7); attn_unit<MODE>(lds, P, bh / P.nh, bh % P.nh, qb, qr0, false, false, 0, 0, 0); }
    } else { const int total = 4 * P.nh * 16;
#define AP_DECODE(L2_, out_) do { const int L_ = (L2_) >> 1, bh_ = (L_ & 7) + 8 * (L_ >> 6); int x_ = (L_ >> 3) & 7; \
            if (MODE == 2 && (G & 63) == 0 && (((L_ - bid) / G) & 1)) x_ = 7 - x_;     \
            out_ = bh_ * 16 + (((L2_) & 1) ? 15 - x_ : x_); } while (0)
        bf16x8 qr[(MODE == 1 ? 192 : 128) / 16];
        bool q_loaded = false;
        for (int L2 = 2 * bid; L2 < total; ) { const int L2n = L2 + ((L2 & 1) ? 2 * G - 1 : 1); const bool has_next = L2n < total;
            int cu, nu = 0; AP_DECODE(L2, cu); if (has_next) AP_DECODE(L2n, nu);
            const int bh = cu >> 4, nbh = nu >> 4;
            attn_unit<MODE>(lds, P, bh / P.nh, bh % P.nh, cu & 15, qr, q_loaded, has_next, nbh / P.nh, nbh % P.nh, nu & 15);
            q_loaded = true; L2 = L2n; }
#undef AP_DECODE
    }
    __builtin_amdgcn_s_setprio(0);
}
struct Params { const float* in[20]; float* out; unsigned char* ws; int ph_lo, ph_hi; };
#ifndef DBG_MASK
#define DBG_MASK 0xFFFF
#endif
#define EN(k) (((DBG_MASK) >> (k)) & 1)
enum { SUB_N = 0, SUB_G1 = 1, SUB_A = 2, SUB_G3 = 3, SUB_G4 = 4, SUB_GLAT = 5, SUB_N1B = 6, SUB_G2 = 7, SUB_KN = 8, SUB_FINAL = 9 };

typedef const __attribute__((address_space(4))) Params* KParams;
DI_ KParams kparams() { auto kp = __builtin_amdgcn_kernarg_segment_ptr(); asm volatile("" : "+s"(kp)); return (KParams)kp; }
#define WSPTRS() KParams kp_ = kparams(); unsigned char* ws = kp_->ws; float* xout = kp_->out; \
    bf16_t* WB = (bf16_t*)(ws + WS_WB); bf16_t* Hb = (bf16_t*)(ws + WS_H); bf16_t* Qb = (bf16_t*)(ws + WS_Q); bf16_t* Kb = (bf16_t*)(ws + WS_K); bf16_t* VTb = (bf16_t*)(ws + WS_VT); \
    float* CS = (float*)(ws + WS_CS); float* LF = (float*)(ws + WS_LF); float* CUM = (float*)(ws + WS_CUM); \
    float* LAT = (float*)(ws + WS_LAT); bf16_t* QG = (bf16_t*)(ws + WS_QG); bf16_t* KL = (bf16_t*)(ws + WS_KL); bf16_t* KVNT = (bf16_t*)(ws + WS_KVNT); \
    bf16_t* QN = (bf16_t*)(ws + WS_QN); bf16_t* KVN = (bf16_t*)(ws + WS_KVN); \
    float* KNL = (float*)(ws + 65536); \
    const float* xin = (l == 0) ? kp_->in[0] : xout; \
    (void)WB; (void)Hb; (void)Qb; (void)Kb; (void)VTb; (void)CS; (void)LF; (void)CUM; (void)LAT; (void)QG; (void)KL; (void)KVNT; (void)QN; (void)KVN; (void)KNL; (void)xin; (void)xout
#define PIN(i) (kp_->in[i])
__global__ void __launch_bounds__(512) fwd_megakernel(Params p) {
    extern __shared__ __attribute__((aligned(16))) unsigned char lds_raw[];
    LAS unsigned char* lds = (LAS unsigned char*)lds_raw;
    cg::grid_group grid = cg::this_grid();
    const int G = gridDim.x, bid = blockIdx.x, NGW = G * 8;
    const int ph_hi = p.ph_hi;
    if (threadIdx.x < 64) ((LAS unsigned*)(lds + LDS_CTL_OFF))[threadIdx.x] = 0u;
    __syncthreads();
    const XcdBarrier xbar = xcd_barrier_post((unsigned*)p.ws, (volatile LAS unsigned*)(lds + LDS_CTL_OFF));
#ifdef DBG_REPEAT
    bool rep_done = false;
#endif
    for (int ph = p.ph_lo; ph < ph_hi; ++ph) {
        int tid_ = threadIdx.x; asm volatile("" : "+v"(tid_));
        const int tid = tid_, lane = tid & 63, wave = __builtin_amdgcn_readfirstlane(tid >> 6), gw = bid * 8 + wave;
        int l, sub, grp = 0;
        if (ph < 5) { l = 0; sub = ph; }
        else if (ph < 12) { l = 1; const int s = ph - 5; sub = s == 0 ? SUB_N : s == 1 ? SUB_GLAT : s == 2 ? SUB_N1B : s == 3 ? SUB_G2 : s == 4 ? SUB_A : s == 5 ? SUB_G3 : SUB_G4; }
        else if (ph < 17) { l = 2; sub = ph - 12; }
        else if (ph < 22) { l = 3; sub = ph - 17; }
        else { l = 4; sub = SUB_FINAL; }

        if (EN(0) && sub == SUB_N) { WSPTRS();
            LAS float* scr = (LAS float*)(lds + wave * 16384);
            if (l == 1) {
                const float* w_in = PIN(6);
                conv_seg(w_in, 2496, 1024, 0, 2496, WB + WB1_LAT, 0, scr, gw, NGW, lane);
                for (int it = gw; it < 256; it += NGW) {
                    if (it < 128) { const int h = it >> 3, kb = (it >> 1) & 3, nb = it & 1; tr_item(PIN(8), 3072, 256, 64 * kb, h * 192 + 128 + 32 * nb, WB + WB1_Q, h * 192 + 128 + 32 * nb, scr, lane); }
                    else { const int i2 = it - 128, kb = i2 >> 6, hb = i2 & 63, head = hb >> 2, dsub = hb & 3; tr_item(PIN(10), 4096, 128, 64 * kb, head * 256 + 128 + 32 * dsub, WB + WB1_V, head * 128 + 32 * dsub, scr, lane); } }
                conv_seg(PIN(11), 1024, 2048, 0, 1024, WB + WB1_O, 0, scr, gw, NGW, lane);
            } else {
                const float* w_in = l == 0 ? PIN(3) : l == 2 ? PIN(13) : PIN(17); const float* w_out = l == 0 ? PIN(4) : l == 2 ? PIN(15) : PIN(18);
                conv_seg(w_in, l == 2 ? 8208 : 8192, 1024, 0, 8192, WB + WB_IN, 0, scr, gw, NGW, lane);
                conv_seg(w_out, 1024, 2048, 0, 1024, WB + WB_O, 0, scr, gw, NGW, lane);
            }
            const float* gain = l == 0 ? PIN(2) : l == 1 ? PIN(5) : l == 2 ? PIN(12) : PIN(16);
            LAS float* wfl = (LAS float*)lds;
            if (l == 2) { __syncthreads();
                for (int idx = tid; idx < 16384; idx += 512) { const int k = idx >> 4, jj = idx & 15; wfl[jj * 1024 + k] = PIN(13)[(size_t)k * 8208 + 8192 + jj]; }
                __syncthreads(); }
            f32x4 nv[4], gg4[4];
#pragma unroll
            for (int jj = 0; jj < 4; ++jj) { gg4[jj] = *(const f32x4*)(gain + 4 * lane + 256 * jj); nv[jj] = gw < T ? *(const f32x4*)(xin + (size_t)gw * DM + 4 * lane + 256 * jj) : (f32x4){0.f, 0.f, 0.f, 0.f}; }
            for (int m = gw; m < T; m += NGW) {
                f32x4 v[4]; float s = 0.f;
#pragma unroll
                for (int jj = 0; jj < 4; ++jj) { v[jj] = nv[jj]; s += (v[jj].x * v[jj].x + v[jj].y * v[jj].y) + (v[jj].z * v[jj].z + v[jj].w * v[jj].w); }
                if (m + NGW < T) {
#pragma unroll
                    for (int jj = 0; jj < 4; ++jj) nv[jj] = *(const f32x4*)(xin + (size_t)(m + NGW) * DM + 4 * lane + 256 * jj); }
                const float r = 1.0f / sqrtf(wave_sum(s) * (1.0f / DM) + EPS);
#pragma unroll
                for (int jj = 0; jj < 4; ++jj) { const f32x4 gg = gg4[jj]; v[jj] = (v[jj] * r) * gg;
                    *(u32x2*)(Hb + (size_t)m * DM + 4 * lane + 256 * jj) = (u32x2){pk2(v[jj].x, v[jj].y), pk2(v[jj].z, v[jj].w)}; }
                if (l == 2) {
                    float a16[16];
#pragma unroll
                    for (int jh = 0; jh < 16; ++jh) { float a = 0.f;
#pragma unroll
                        for (int jj = 0; jj < 4; ++jj) { const f32x4 w = *(const LAS f32x4*)(wfl + jh * 1024 + 4 * lane + 256 * jj); a += (v[jj].x * w.x + v[jj].y * w.y) + (v[jj].z * w.z + v[jj].w * w.w); }
                        a16[jh] = a; }
                    float a8[8], a4[4], a2[2], a1;
                    { const bool up = (lane & 32) != 0;
#pragma unroll
                      for (int i = 0; i < 8; ++i) { const float keep = up ? a16[8 + i] : a16[i], send = up ? a16[i] : a16[8 + i]; a8[i] = keep + __shfl_xor(send, 32); } }
                    { const bool up = (lane & 16) != 0;
#pragma unroll
                      for (int i = 0; i < 4; ++i) { const float keep = up ? a8[4 + i] : a8[i], send = up ? a8[i] : a8[4 + i]; a4[i] = keep + __shfl_xor(send, 16); } }
                    { const bool up = (lane & 8) != 0;
#pragma unroll
                      for (int i = 0; i < 2; ++i) { const float keep = up ? a4[2 + i] : a4[i], send = up ? a4[i] : a4[2 + i]; a2[i] = keep + __shfl_xor(send, 8); } }
                    { const bool up = (lane & 4) != 0; const float keep = up ? a2[1] : a2[0], send = up ? a2[0] : a2[1]; a1 = keep + __shfl_xor(send, 4); }
                    a1 += __shfl_xor(a1, 2); a1 += __shfl_xor(a1, 1);
                    if ((lane & 3) == 0) { const int jh = ((lane >> 5) & 1) * 8 + ((lane >> 4) & 1) * 4 + ((lane >> 3) & 1) * 2 + ((lane >> 2) & 1);
                        const float f = a1 + PIN(14)[jh]; LF[(size_t)m * 16 + jh] = -(fmaxf(-f, 0.f) + log1pf(expf(-fabsf(f)))); } }
            }
            if (l == 2) __syncthreads();
        } else if (EN(1) && (sub == SUB_G1 || sub == SUB_G2)) { WSPTRS();
            if (l == 2 && bid < 64) {
                const int b = bid >> 4, h = bid & 15; float v[8]; float run = 0.f;
#pragma unroll
                for (int e = 0; e < 8; ++e) { run += LF[((size_t)b * SEQ + 8 * tid + e) * 16 + h]; v[e] = run; }
                float inc = run;
#pragma unroll
                for (int o = 1; o < 64; o <<= 1) { const float t = __shfl_up(inc, o); if (lane >= o) inc += t; }
                LAS float* wt = (LAS float*)lds;
                if (lane == 63) wt[wave] = inc;
                __syncthreads();
                float off = inc - run;
                for (int w = 0; w < wave; ++w) off += wt[w];
                float* cp = CUM + ((size_t)b * NH + h) * SEQ + 8 * tid;
                *(f32x4*)cp = (f32x4){v[0] + off, v[1] + off, v[2] + off, v[3] + off} * (-LOG2E); *(f32x4*)(cp + 4) = (f32x4){v[4] + off, v[5] + off, v[6] + off, v[7] + off} * (-LOG2E);
                __syncthreads();
            }
            const int ng = 2;
            for (int gi = 0; gi < ng; ++gi) {
                pg8::Gemm g; pg8::EpiBf16K E; E.split_cols = 0; E.split_stride = 0; E.knp = nullptr;
                if (sub == SUB_G1) {
                    if (gi == 0) { g = pg8::Gemm{Hb, WB + WB_IN, T, l == 2 ? 4096 : 6144, 1024}; E.O = Qb; E.ldc = 2048; E.split_cols = 2048; E.split_stride = (size_t)(WS_K - WS_Q) / 2; if (l == 2) E.knp = CS; }
                    else { if (l != 2) continue; g = pg8::Gemm{WB + WB_IN + (size_t)4096 * 1024, Hb, 2048, T, 1024}; E.O = VTb; E.ldc = T; }
                } else {
                    if (gi == 0) { g = pg8::Gemm{QN, WB + WB1_Q, T, 3072, 256}; E.O = QG; E.ldc = 3072; }
                    else continue;
                }
                pg8::StaticOrder S; S.init(g.M, g.N, G, bid);
                pg8::gemm_phase<pg8::EpiBf16K, pg8::StaticOrder, true, true>(lds, g, S, E);
            }
        } else if (EN(2) && sub == SUB_GLAT) { WSPTRS();
            { const int jb0 = G > 128 ? bid - 128 : bid, jbs = G > 128 ? G - 128 : G;
              if (jb0 >= 0) {
                {
                const int* pos = (const int*)PIN(1);
                for (int idx = jb0 * 512 + tid; idx < T * 32; idx += jbs * 512) { const int tok = idx >> 5, i = idx & 31;
                    const float invf = powf(10000.0f, -(float)(2 * i) / 64.0f); const float ang = (float)pos[tok] * invf;
                    const double ad = (double)ang, kq = rint(ad * 0.15915494309189535); const float rf = (float)(ad - kq * 6.283185307179586);
                    CS[idx] = cosf(rf); CS[(size_t)T * 32 + idx] = sinf(rf); }
                }
                { LAS float* wkv = (LAS float*)lds; LAS float* wql = wkv + 128 * 132;
                  for (int job = jb0; job < 128; job += jbs) { const int h = job >> 3, kg = job & 7;
                      for (int idx = tid; idx < 128 * 32; idx += 512) { const int c = idx >> 5, d4 = idx & 31; *(LAS f32x4*)(wkv + c * 132 + 4 * d4) = *(const f32x4*)(PIN(10) + (size_t)c * 4096 + h * 256 + 4 * d4); }
                      for (int idx = tid; idx < 32 * 32; idx += 512) { const int kl = idx >> 5, d4 = idx & 31; *(LAS f32x4*)(wql + kl * 132 + 4 * d4) = *(const f32x4*)(PIN(8) + (size_t)(kg * 32 + kl) * 3072 + h * 192 + 4 * d4); }
                      __syncthreads();
                      const int kl = tid >> 4, cg = tid & 15; float acc[8];
#pragma unroll
                      for (int i = 0; i < 8; ++i) acc[i] = 0.f;
#pragma unroll 4
                      for (int d4 = 0; d4 < 32; ++d4) { const f32x4 q = *(const LAS f32x4*)(wql + kl * 132 + 4 * d4);
#pragma unroll
                          for (int i = 0; i < 8; ++i) { const f32x4 w = *(const LAS f32x4*)(wkv + (cg + 16 * i) * 132 + 4 * d4); acc[i] += (q.x * w.x + q.y * w.y) + (q.z * w.z + q.w * w.w); } }
#pragma unroll
                      for (int i = 0; i < 8; ++i) WB[WB1_Q + (size_t)(h * 192 + cg + 16 * i) * 256 + kg * 32 + kl] = (bf16_t)(pk2(acc[i], 0.f) & 0xffffu);
                      __syncthreads(); } }
              } }
            pg8::Gemm g{Hb, WB + WB1_LAT, T, 512, 1024}; pg8::EpiF32<false> E{nullptr, LAT, 512};
            pg8::StaticOrder S; S.init(g.M, g.N, G, bid);
            pg8::gemm_phase<pg8::EpiF32<false>, pg8::StaticOrder, true, true>(lds, g, S, E);
        } else if (EN(9) && sub == SUB_G4) { WSPTRS();
            bf16_t* A = Qb;
            pg8::Gemm g{A, WB + (l == 1 ? WB1_O : WB_O), T, 1024, 2048}; pg8::EpiF32<true> E{xin, xout, 1024};
            pg8::StaticOrder S; S.init(g.M, g.N, G, bid);
            pg8::gemm_phase<pg8::EpiF32<true>, pg8::StaticOrder, true, true>(lds, g, S, E);
        } else if (EN(3) && sub == SUB_G3) { WSPTRS();
            pg8::Gemm g{Hb, WB + (l == 1 ? WB1_G : WB_IN + (size_t)6144 * 1024), T, 2048, 1024}; pg8::EpiGate E{Qb, 2048};
            pg8::StaticOrder S; S.init(g.M, g.N, G, bid);
            pg8::gemm_phase<pg8::EpiGate, pg8::StaticOrder, true, true>(lds, g, S, E);
        } else if (EN(4) && sub == SUB_N1B) { WSPTRS();
            const f32x4 gq = *(const f32x4*)(PIN(7) + 4 * lane), gk = *(const f32x4*)(PIN(9) + 4 * (lane & 31));
            f32x4 na = (f32x4){0.f, 0.f, 0.f, 0.f}, nb = na;
            if (gw < T) { na = *(const f32x4*)(LAT + (size_t)gw * 512 + 4 * lane); nb = *(const f32x4*)(LAT + (size_t)gw * 512 + 256 + 4 * lane); }
            for (int m = gw; m < T; m += NGW) {
                const f32x4 a = na, bq = nb;
                if (m + NGW < T) { na = *(const f32x4*)(LAT + (size_t)(m + NGW) * 512 + 4 * lane); nb = *(const f32x4*)(LAT + (size_t)(m + NGW) * 512 + 256 + 4 * lane); }
                const float rq = 1.0f / sqrtf(wave_sum((a.x * a.x + a.y * a.y) + (a.z * a.z + a.w * a.w)) * (1.0f / 256.0f) + EPS);
                const f32x4 yq = (a * rq) * gq;
                *(u32x2*)(QN + (size_t)m * 256 + 4 * lane) = (u32x2){pk2(yq.x, yq.y), pk2(yq.z, yq.w)};
                const float sk = lane < 32 ? (bq.x * bq.x + bq.y * bq.y) + (bq.z * bq.z + bq.w * bq.w) : 0.f;
                const float rk = 1.0f / sqrtf(wave_sum(sk) * (1.0f / 128.0f) + EPS);
                float kk2 = 0.f;
                if (lane < 32) { const f32x4 yk = (bq * rk) * gk; kk2 = (yk.x * yk.x + yk.y * yk.y) + (yk.z * yk.z + yk.w * yk.w);
                    *(u32x2*)(KL + (size_t)m * 192 + 4 * lane) = (u32x2){pk2(yk.x, yk.y), pk2(yk.z, yk.w)}; }
                f32x4 pr; pr.x = __shfl_xor(bq.x, 8); pr.y = __shfl_xor(bq.y, 8); pr.z = __shfl_xor(bq.z, 8); pr.w = __shfl_xor(bq.w, 8);
                if (lane >= 32 && lane < 48) { const int i0 = 4 * (lane & 7); const bool second = lane >= 40;
                    const f32x4 c = *(const f32x4*)(CS + (size_t)m * 32 + i0), s = *(const f32x4*)(CS + (size_t)T * 32 + (size_t)m * 32 + i0);
                    const f32x4 x1 = second ? pr : bq, x2 = second ? bq : pr;
                    const f32x4 y = second ? (x1 * s + x2 * c) : (x1 * c - x2 * s);
                    *(u32x2*)(KL + (size_t)m * 192 + 128 + 4 * (lane - 32)) = (u32x2){pk2(y.x, y.y), pk2(y.z, y.w)}; kk2 = (y.x * y.x + y.y * y.y) + (y.z * y.z + y.w * y.w); }
                kk2 = wave_sum(kk2); if (lane == 0) KNL[m] = kk2;
            }
        } else if (sub == SUB_A) { WSPTRS();
            AttnP P; P.cum = CUM; P.cs = CS; P.KR = nullptr; P.kn2 = CS;
            P.khead = 128; P.vheadrows = 128; P.krpitch = 64; P.WV = WB + WB1_V;
            if (EN(6) && l == 1) { P.Q = QG; P.K = KL; P.KR = KL + 128; P.VT = KVNT; P.O = Qb; P.qpitch = 3072; P.kpitch = 192; P.krpitch = 192; P.khead = 0; P.vheadrows = 0; P.opitch = 2048; P.nh = 16; P.kn2 = KNL;
#if defined(DBG_REPEAT) && defined(DBG_VAR)
                attn_phase<1>(lds, P, G, bid, (ph == DBG_REPEAT && !rep_done) ? DBG_VAR : 0); }
#else
                attn_phase<1>(lds, P, G, bid); }
#endif
            else { P.Q = Qb; P.K = Kb; P.VT = VTb; P.O = Qb; P.qpitch = 2048; P.kpitch = 2048; P.opitch = 2048; P.nh = 16;
                if (EN(7) && l == 2) attn_phase<2>(lds, P, G, bid); else if (EN(5)) {
                    stick_wave_phase(lds, P, gw, NGW);
                } }
        } else if (EN(8)) { WSPTRS();
            f32x4 nv[4], gg4[4];
#pragma unroll
            for (int jj = 0; jj < 4; ++jj) { gg4[jj] = *(const f32x4*)(PIN(19) + 4 * lane + 256 * jj); nv[jj] = gw < T ? *(const f32x4*)(xout + (size_t)gw * DM + 4 * lane + 256 * jj) : (f32x4){0.f, 0.f, 0.f, 0.f}; }
            for (int m = gw; m < T; m += NGW) {
                float* xr = xout + (size_t)m * DM + 4 * lane; f32x4 v[4]; float s = 0.f;
#pragma unroll
                for (int jj = 0; jj < 4; ++jj) { v[jj] = nv[jj]; s += (v[jj].x * v[jj].x + v[jj].y * v[jj].y) + (v[jj].z * v[jj].z + v[jj].w * v[jj].w); }
                if (m + NGW < T) {
#pragma unroll
                    for (int jj = 0; jj < 4; ++jj) nv[jj] = *(const f32x4*)(xout + (size_t)(m + NGW) * DM + 4 * lane + 256 * jj); }
                const float r = 1.0f / sqrtf(wave_sum(s) * (1.0f / DM) + EPS);
#pragma unroll
                for (int jj = 0; jj < 4; ++jj) *(f32x4*)(xr + 256 * jj) = (v[jj] * r) * gg4[jj];
            }
        }
        if (ph + 1 < ph_hi) { if (p.ph_lo < 0) grid.sync(); else xcd_barrier(xbar); }
#ifdef DBG_REPEAT
        if (ph == DBG_REPEAT && !rep_done) { rep_done = true; --ph; }
#endif
    }
}

extern "C" void kernel_launch(void* const* d_in, const int* in_sizes, int n_in, void* d_out, int out_size, void* d_ws, size_t ws_size, hipStream_t stream) {
    static int grid = 0;
    if (grid == 0) {
        if (n_in != 20 || in_sizes[0] != T * DM || out_size != T * DM || ws_size < WS_END) { fprintf(stderr, "kernel_launch: unexpected shapes (n_in %d, in0 %d, out %d, ws %zu)\n", n_in, n_in > 0 ? in_sizes[0] : -1, out_size, ws_size); grid = -1; return; }
        int dev = 0, cus = 0, per_cu = 0;
        (void)hipGetDevice(&dev); (void)hipDeviceGetAttribute(&cus, hipDeviceAttributeMultiprocessorCount, dev);
        if (hipFuncSetAttribute((const void*)fwd_megakernel, hipFuncAttributeMaxDynamicSharedMemorySize, LDS_BYTES) != hipSuccess) { fprintf(stderr, "kernel_launch: hipFuncSetAttribute failed\n"); grid = -1; return; }
        if (hipOccupancyMaxActiveBlocksPerMultiprocessor(&per_cu, (const void*)fwd_megakernel, 512, LDS_BYTES) != hipSuccess || per_cu < 1) { fprintf(stderr, "kernel_launch: occupancy query says %d\n", per_cu); per_cu = 1; }
        (void)hipGetLastError();
        if (cus <= 0) cus = 256;
        grid = cus;
    }
    if (grid < 0) return;
    if (hipMemsetAsync(d_ws, 0, 16384, stream) != hipSuccess) { fprintf(stderr, "kernel_launch: memset failed\n"); return; }
    Params p{};
    for (int i = 0; i < 20; ++i) p.in[i] = (const float*)d_in[i];
    p.out = (float*)d_out; p.ws = (unsigned char*)d_ws;
#if MK_ONE_LAUNCH
    p.ph_lo = 0; p.ph_hi = NPH;
    void* args[] = {&p};
    hipError_t e = hipLaunchCooperativeKernel((const void*)fwd_megakernel, dim3(grid), dim3(512), args, LDS_BYTES, stream);
    if (e != hipSuccess) fprintf(stderr, "kernel_launch: cooperative launch failed: %s (grid %d)\n", hipGetErrorString(e), grid);
#else
    for (int ph = 0; ph < NPH; ++ph) { p.ph_lo = ph; p.ph_hi = ph + 1; hipLaunchKernelGGL(fwd_megakernel, dim3(grid), dim3(512), LDS_BYTES, stream, p); }
#endif
}
```

```cpp
#include <hip/hip_runtime.h>
#include <hip/hip_cooperative_groups.h>
#include <cstdio>
#include <cstdint>
#include <cmath>
namespace cg = cooperative_groups;
#ifndef MK_ONE_LAUNCH
#define MK_ONE_LAUNCH 1
#endif
namespace pg8 {
#define PG8_LAS __attribute__((address_space(3)))
typedef unsigned short bf16_t;
typedef short bf16x8 __attribute__((ext_vector_type(8)));
typedef float f32x4 __attribute__((ext_vector_type(4)));
typedef unsigned u32x4 __attribute__((ext_vector_type(4)));
constexpr int BM = 256, BK = 64, HALF = 128, HTB = HALF * BK * 2  , STAGE_BYTES = 8 * HTB, NXCD = 8, WGM = 8;

__host__ __device__ __forceinline__ int lds_byte(int r, int c) { const int st = (r >> 4) * 2 + (c >> 5), rr = r & 15, cc = c & 31, ob = rr * 64 + cc * 2; return st * 1024 + (ob ^ (((ob >> 9) & 1) << 5)); }
__host__ __device__ __forceinline__ void stage_rc(int b, int& R, int& C) { const int st = b / 1024, sb = b % 1024, swz = sb ^ (((sb >> 9) & 1) << 5); R = (st >> 1) * 16 + swz / 64; C = (st & 1) * 32 + (swz % 64) / 2; }
__host__ __device__ __forceinline__ int perm32(int rho) { const int n = rho >> 4, i = rho & 15; return 8 * (i >> 2) + 4 * n + (i & 3); }

struct Unit { int pm, pn; };
struct Gemm { const bf16_t* A; const bf16_t* Bt; int M, N, K; };

struct StaticOrder {
    int nM, nN, nwg, G, c;
    __host__ __device__ void init(int M, int N, int G_, int c_) { nM = M / BM; nN = N / BM; nwg = nM * nN; G = G_; c = c_; }
    __host__ __device__ bool next(int i, Unit& u) const {
        const long L = (long)i * G + c; if (L >= nwg) return false;
        int wgid = (int)L; { const int q = nwg / NXCD, r = nwg % NXCD, xcd = wgid % NXCD, off = wgid / NXCD; wgid = (xcd < r ? xcd * (q + 1) : r * (q + 1) + (xcd - r) * q) + off; }
        const int nig = WGM * nN, gid = wgid / nig, fm = gid * WGM, gsz = (nM - fm) < WGM ? (nM - fm) : WGM;
        u.pm = fm + ((wgid % nig) % gsz); u.pn = (wgid % nig) / gsz; return true;
    }
    __device__ __forceinline__ void a_ready(const Unit&) const {}
    __device__ __forceinline__ void done(const Unit&) const {}
};

__device__ __forceinline__ unsigned cvt_pk_bf16(float lo, float hi) { unsigned r; asm volatile("v_cvt_pk_bf16_f32 %0, %1, %2" : "=v"(r) : "v"(lo), "v"(hi)); return r; }
typedef float f32x2 __attribute__((ext_vector_type(2)));
__device__ __forceinline__ f32x2 gelu_pk(f32x2 v) {
    const f32x2 av = __builtin_elementwise_abs(v), d = av * 0.2316418882f + 1.0f;
    f32x2 t; t.x = __builtin_amdgcn_rcpf(d.x); t.y = __builtin_amdgcn_rcpf(d.y);
    f32x2 q = t * 0.5307027145f + (-0.7265760135f); q = q * t + 0.7107068705f; q = q * t + (-0.142248368f); q = q * t + 0.127414796f; q = q * t;
    const f32x2 s = (v * v) * (-0.72134752044f);
    f32x2 e; e.x = __builtin_amdgcn_exp2f(s.x); e.y = __builtin_amdgcn_exp2f(s.y);
    const f32x2 m = v * (q * e), r = v - m;
    f32x2 o; o.x = v.x < 0.f ? m.x : r.x; o.y = v.y < 0.f ? m.y : r.y; return o;
}

template <int ACT  > struct EpiBf16 {
    static constexpr bool PERM = true, AFTER_DRAIN = false; static_assert(ACT == 0 || ACT == 1, "EpiBf16: ACT is 0 (none) or 1 (gelu_pk)");
    bf16_t* O; int ldc; const float* bias; int split_cols; size_t split_stride; float scale0;
    __device__ __forceinline__ void operator()(const f32x4 (&acc)[2][2][4][2], const Unit& u, int wr, int wc, int fr, int fq) const {
        const int row0 = u.pm * BM + wr * 64 + fr; int colt = u.pn * BM; bf16_t* base = O;
        float sc = 1.f; if (split_cols) { const int t = colt / split_cols; base += (size_t)t * split_stride; colt -= t * split_cols; if (t == 0) sc = scale0; }
        const int col0 = colt + wc * 32 + 8 * fq, bcol0 = u.pn * BM + wc * 32 + 8 * fq;
        f32x4 bv[2][2];
#pragma unroll
        for (int bj = 0; bj < 2; ++bj)
#pragma unroll
            for (int n = 0; n < 2; ++n) bv[bj][n] = bias ? *(const f32x4*)(bias + bcol0 + bj * HALF + 4 * n) : (f32x4){0.f, 0.f, 0.f, 0.f};
#pragma unroll
        for (int ai = 0; ai < 2; ++ai)
#pragma unroll
            for (int m = 0; m < 4; ++m) { bf16_t* rowp = base + (size_t)(row0 + ai * HALF + m * 16) * ldc + col0;
#pragma unroll
                for (int bj = 0; bj < 2; ++bj) { f32x4 v0 = acc[ai][bj][m][0] + bv[bj][0], v1 = acc[ai][bj][m][1] + bv[bj][1];
                    if (ACT == 1) { f32x2 a = gelu_pk((f32x2){v0[0], v0[1]}), b = gelu_pk((f32x2){v0[2], v0[3]}), c = gelu_pk((f32x2){v1[0], v1[1]}), d = gelu_pk((f32x2){v1[2], v1[3]});
                        v0 = (f32x4){a.x, a.y, b.x, b.y}; v1 = (f32x4){c.x, c.y, d.x, d.y}; }
                    v0 = v0 * sc; v1 = v1 * sc; u32x4 w; w.x = cvt_pk_bf16(v0[0], v0[1]); w.y = cvt_pk_bf16(v0[2], v0[3]); w.z = cvt_pk_bf16(v1[0], v1[1]); w.w = cvt_pk_bf16(v1[2], v1[3]);
                    *(u32x4*)(rowp + bj * HALF) = w; } }
    }
};

struct PanelStats {
    unsigned* xbuf;
    unsigned* cnt;
    unsigned* tmo;
    int ntn; float eps;
    unsigned code;
    __device__ __forceinline__ bool run(const f32x4 (&v)[2][2][4][2], const Unit& u, int wr, int wc, int fr, int fq, PG8_LAS unsigned char* lds, int wid, int lane) const {
        typedef float f32x2v __attribute__((ext_vector_type(2)));
        PG8_LAS f32x2v* P = (PG8_LAS f32x2v*)lds;
        PG8_LAS f32x2v* S = (PG8_LAS f32x2v*)(lds + 8192);
        PG8_LAS unsigned* flag = (PG8_LAS unsigned*)(lds + 8192 + 2048);
#pragma unroll
        for (int ai = 0; ai < 2; ++ai)
#pragma unroll
            for (int m = 0; m < 4; ++m) {
                float s = 0.f;
#pragma unroll
                for (int bj = 0; bj < 2; ++bj)
#pragma unroll
                    for (int n = 0; n < 2; ++n) { const f32x4 x = v[ai][bj][m][n]; s += (x[0] + x[1]) + (x[2] + x[3]); }
                s += __shfl_xor(s, 16); s += __shfl_xor(s, 32);
                const float mw = s * (1.0f / 64.0f); float q = 0.f;
#pragma unroll
                for (int bj = 0; bj < 2; ++bj)
#pragma unroll
                    for (int n = 0; n < 2; ++n) { const f32x4 d = v[ai][bj][m][n] - mw; q += (d[0] * d[0] + d[1] * d[1]) + (d[2] * d[2] + d[3] * d[3]); }
                q += __shfl_xor(q, 16); q += __shfl_xor(q, 32);
                if (fq == 0) P[(ai * HALF + wr * 64 + m * 16 + fr) * 4 + wc] = (f32x2v){mw, q};
            }
        asm volatile("s_waitcnt lgkmcnt(0)" ::: "memory"); __builtin_amdgcn_s_barrier(); asm volatile("" ::: "memory");
#if defined(BROKEN_EXCHANGE_NO_WAIT)
#warning BROKEN CONTROL BUILD: the row-statistics exchange does not wait; results are wrong by design
        if (blockIdx.x >= 64) { const long long t0_ = clock64(); while (clock64() - t0_ < 60000) __builtin_amdgcn_s_sleep(8); }
#endif
        const int row = wid * 32 + (lane & 31);
        if (lane < 32) {
            const f32x2v a = P[row * 4 + 0], b = P[row * 4 + 1], c = P[row * 4 + 2], d = P[row * 4 + 3];
            const float mt = (a.x + b.x + c.x + d.x) * 0.25f;
            const float da = a.x - mt, db = b.x - mt, dc = c.x - mt, dd = d.x - mt;
            const float m2 = (a.y + b.y) + (c.y + d.y) + 64.0f * ((da * da + db * db) + (dc * dc + dd * dd));
            unsigned long long* slot = (unsigned long long*)xbuf + ((size_t)(u.pm * BM + row) * 4 + u.pn);
            __hip_atomic_store(slot, ((unsigned long long)__float_as_uint(m2) << 32) | __float_as_uint(mt), __ATOMIC_RELAXED, __HIP_MEMORY_SCOPE_AGENT);
        }
        asm volatile("s_waitcnt vmcnt(0)" ::: "memory");
        if (lane == 0) __hip_atomic_fetch_add(cnt + 64 * u.pm, 1u, __ATOMIC_RELAXED, __HIP_MEMORY_SCOPE_AGENT);
        if (wid == 0) {
            bool dead = false; const unsigned long long t0 = __builtin_amdgcn_s_memrealtime(); const unsigned want = 8u * (unsigned)ntn;
            for (;;) {
#if defined(BROKEN_EXCHANGE_NO_WAIT)
                break;
#endif
                if ((unsigned)__builtin_amdgcn_readfirstlane(__hip_atomic_load(cnt + 64 * u.pm, __ATOMIC_RELAXED, __HIP_MEMORY_SCOPE_AGENT)) >= want) break;
                if (__builtin_amdgcn_s_memrealtime() - t0 > 2000000ull) {
                    if (lane == 0) { unsigned expect = 0u; __hip_atomic_compare_exchange_strong(tmo + 1, &expect, code | (unsigned)(u.pm & 0xff), __ATOMIC_RELAXED, __ATOMIC_RELAXED, __HIP_MEMORY_SCOPE_AGENT);
                                     __hip_atomic_store(tmo, 1u, __ATOMIC_RELAXED, __HIP_MEMORY_SCOPE_AGENT); }
                    dead = true; break; }
                __builtin_amdgcn_s_sleep(2);
            }
            __builtin_amdgcn_fence(__ATOMIC_ACQUIRE, "agent");
            if (lane == 0) flag[0] = dead ? 1u : 0u;
        }
        asm volatile("s_waitcnt vmcnt(0) lgkmcnt(0)" ::: "memory"); __builtin_amdgcn_s_barrier(); asm volatile("" ::: "memory");
        const bool bad = flag[0] != 0u;
        if (lane < 32) {
            const unsigned long long* slot = (const unsigned long long*)xbuf + (size_t)(u.pm * BM + row) * 4; float mt[4], m2[4]; float ms = 0.f;
#pragma unroll
            for (int t = 0; t < 4; ++t) { if (t < ntn) { const unsigned long long w = __hip_atomic_load(slot + t, __ATOMIC_RELAXED, __HIP_MEMORY_SCOPE_AGENT); mt[t] = __uint_as_float((unsigned)w); m2[t] = __uint_as_float((unsigned)(w >> 32)); } else { mt[t] = 0.f; m2[t] = 0.f; } ms += mt[t]; }
            const float mean = ms / (float)ntn; float q = 0.f;
#pragma unroll
            for (int t = 0; t < 4; ++t) if (t < ntn) { const float dm = mt[t] - mean; q += m2[t] + 256.0f * dm * dm; }
            S[row] = (f32x2v){mean, 1.0f / sqrtf(q / (256.0f * (float)ntn) + eps)};
        }
        asm volatile("s_waitcnt lgkmcnt(0)" ::: "memory"); __builtin_amdgcn_s_barrier(); asm volatile("" ::: "memory");
        return bad;
    }
};
struct EpiLnRes {
    static constexpr bool PERM = false, AFTER_DRAIN = true;
    const float* base; float* out; int ldc; const float* bias; PanelStats st; unsigned poison;
    __device__ __forceinline__ void fused(f32x4 (&acc)[2][2][4][2], const Unit& u, int wr, int wc, int fr, int fq, PG8_LAS unsigned char* lds, int wid, int lane) const {
        typedef float f32x2v __attribute__((ext_vector_type(2)));
        const PG8_LAS f32x2v* S = (const PG8_LAS f32x2v*)(lds + 8192);
        const int col0 = u.pn * BM + wc * 32 + 4 * fq;
#pragma unroll
        for (int bj = 0; bj < 2; ++bj)
#pragma unroll
            for (int n = 0; n < 2; ++n) { const f32x4 bv = bias ? *(const f32x4*)(bias + col0 + bj * HALF + n * 16) : (f32x4){0.f, 0.f, 0.f, 0.f};
#pragma unroll
                for (int ai = 0; ai < 2; ++ai)
#pragma unroll
                    for (int m = 0; m < 4; ++m) acc[ai][bj][m][n] += bv; }
        f32x4 pre[4][2][2];
#pragma unroll
        for (int m = 0; m < 4; ++m) { const size_t off = (size_t)(u.pm * BM + wr * 64 + m * 16 + fr) * ldc + col0;
#pragma unroll
            for (int bj = 0; bj < 2; ++bj)
#pragma unroll
                for (int n = 0; n < 2; ++n) pre[m][bj][n] = *(const f32x4*)(base + off + bj * HALF + n * 16); }
        const bool bad = st.run(acc, u, wr, wc, fr, fq, lds, wid, lane) || poison != 0u;
        const float qnan = __builtin_nanf("");
#pragma unroll
        for (int ai = 0; ai < 2; ++ai)
#pragma unroll
            for (int m = 0; m < 4; ++m) { const int r = ai * HALF + wr * 64 + m * 16 + fr; const f32x2v sr = S[r]; const size_t off = (size_t)(u.pm * BM + r) * ldc + col0;
#pragma unroll
                for (int bj = 0; bj < 2; ++bj)
#pragma unroll
                    for (int n = 0; n < 2; ++n) { const f32x4 bs = ai == 0 ? pre[m][bj][n] : *(const f32x4*)(base + off + bj * HALF + n * 16); f32x4 o = bs + (acc[ai][bj][m][n] - sr.x) * sr.y;
                        if (bad) o = (f32x4){qnan, qnan, qnan, qnan}; *(f32x4*)(out + off + bj * HALF + n * 16) = o; }
                if (m & 1) asm volatile("" ::: "memory"); }
    }
};
struct EpiLnResLn {
    static constexpr bool PERM = false, AFTER_DRAIN = true;
    const float* base; float* out; bf16_t* xn; int ldc; const float* bias; PanelStats st1, st2; unsigned poison;
    __device__ __forceinline__ void fused(f32x4 (&acc)[2][2][4][2], const Unit& u, int wr, int wc, int fr, int fq, PG8_LAS unsigned char* lds, int wid, int lane) const {
        typedef float f32x2v __attribute__((ext_vector_type(2))); typedef unsigned u32x2v __attribute__((ext_vector_type(2)));
        const PG8_LAS f32x2v* S = (const PG8_LAS f32x2v*)(lds + 8192);
        const int col0 = u.pn * BM + wc * 32 + 4 * fq;
#pragma unroll
        for (int bj = 0; bj < 2; ++bj)
#pragma unroll
            for (int n = 0; n < 2; ++n) { const f32x4 bv = bias ? *(const f32x4*)(bias + col0 + bj * HALF + n * 16) : (f32x4){0.f, 0.f, 0.f, 0.f};
#pragma unroll
                for (int ai = 0; ai < 2; ++ai)
#pragma unroll
                    for (int m = 0; m < 4; ++m) acc[ai][bj][m][n] += bv; }
        bool bad = st1.run(acc, u, wr, wc, fr, fq, lds, wid, lane) || poison != 0u;
        const float qnan = __builtin_nanf("");
#pragma unroll
        for (int ai = 0; ai < 2; ++ai)
#pragma unroll
            for (int m = 0; m < 4; ++m) { const int r = ai * HALF + wr * 64 + m * 16 + fr; const f32x2v sr = S[r]; const size_t off = (size_t)(u.pm * BM + r) * ldc + col0;
#pragma unroll
                for (int bj = 0; bj < 2; ++bj)
#pragma unroll
                    for (int n = 0; n < 2; ++n) { const f32x4 bs = *(const f32x4*)(base + off + bj * HALF + n * 16); acc[ai][bj][m][n] = bs + (acc[ai][bj][m][n] - sr.x) * sr.y; }
                asm volatile("" : "+v"(acc[ai][0][m][0]), "+v"(acc[ai][0][m][1]), "+v"(acc[ai][1][m][0]), "+v"(acc[ai][1][m][1]));
                if (m & 1) asm volatile("" ::: "memory"); }
        const bool bad1 = bad;
        bad = st2.run(acc, u, wr, wc, fr, fq, lds, wid, lane) || bad;
#pragma unroll
        for (int ai = 0; ai < 2; ++ai)
#pragma unroll
            for (int m = 0; m < 4; ++m) { const int r = ai * HALF + wr * 64 + m * 16 + fr; const f32x2v sr = S[r]; const size_t off = (size_t)(u.pm * BM + r) * ldc + col0;
#pragma unroll
                for (int bj = 0; bj < 2; ++bj)
#pragma unroll
                    for (int n = 0; n < 2; ++n) { const f32x4 x1 = acc[ai][bj][m][n]; *(f32x4*)(out + off + bj * HALF + n * 16) = bad1 ? (f32x4){qnan, qnan, qnan, qnan} : x1;
                        const f32x4 o = (x1 - sr.x) * sr.y; u32x2v w; w.x = cvt_pk_bf16(o[0], o[1]); w.y = cvt_pk_bf16(o[2], o[3]);
                        if (bad) { w.x = 0x7fc07fc0u; w.y = 0x7fc07fc0u; } *(u32x2v*)(xn + off + bj * HALF + n * 16) = w; }
                asm volatile("" ::: "memory"); }
    }
};

template <class Epi, class Sched, bool ALIGN_EPI = false, bool SP2 = false>
__device__ __forceinline__ void gemm_phase(PG8_LAS unsigned char* lds, const Gemm g, const Sched& S, const Epi& E) {
    int tid_ = threadIdx.x; asm volatile("" : "+v"(tid_));
    const int tid = tid_, wid = __builtin_amdgcn_readfirstlane(tid >> 6), lane = tid & 63, wr = wid >> 2, wc = wid & 3, fr = lane & 15, fq = lane >> 4;
    const int K = g.K, nt = K / BK;
    unsigned voffA[2], voffB[2];
#pragma unroll
    for (int i = 0; i < 2; ++i) { int R, C; stage_rc(tid * 16 + i * 8192, R, C); const int Rb = Epi::PERM ? ((R & ~31) + perm32(R & 31)) : R;
        voffA[i] = (unsigned)(R * K + C) * 2u; voffB[i] = (unsigned)(Rb * K + C) * 2u; }
    const size_t kstep = (size_t)(BK * 2);
    const size_t hstep = (size_t)HALF * K * 2;
    const size_t tstep = 2 * hstep;
    const unsigned ldsw = (unsigned)wid * 1024u;
    const int aoff = lds_byte(wr * 64 + fr, fq * 8), boff = lds_byte(wc * 32 + fr, fq * 8);
#define PG8_SA(b, h) (((b) * 2 + (h)) * HTB)
#define PG8_SB(b, h) ((4 + (b) * 2 + (h)) * HTB)
#define PG8_STAGE(bufoff, gbase, voff) do { _Pragma("unroll") for (int _i = 0; _i < 2; ++_i) \
        __builtin_amdgcn_global_load_lds((const unsigned*)((const char*)(gbase) + (voff)[_i]), (PG8_LAS unsigned*)(lds + (bufoff) + ldsw + _i * 8192), 16, 0, 0); } while (0)
#define PG8_LDA(dst, b, h) do { _Pragma("unroll") for (int m = 0; m < 4; ++m) _Pragma("unroll") for (int k = 0; k < 2; ++k) dst[m][k] = *(const PG8_LAS bf16x8*)(lds + PG8_SA(b, h) + aoff + m * 2048 + k * 1024); } while (0)
#define PG8_LDB(dst, b, h) do { _Pragma("unroll") for (int n = 0; n < 2; ++n) _Pragma("unroll") for (int k = 0; k < 2; ++k) dst[n][k] = *(const PG8_LAS bf16x8*)(lds + PG8_SB(b, h) + boff + n * 2048 + k * 1024); } while (0)
#define PG8_MMA(ai, bj, At, Bt) do { __builtin_amdgcn_s_setprio(1); _Pragma("unroll") for (int m = 0; m < 4; ++m) _Pragma("unroll") for (int n = 0; n < 2; ++n) _Pragma("unroll") for (int k = 0; k < 2; ++k) \
        acc[ai][bj][m][n] = __builtin_amdgcn_mfma_f32_16x16x32_bf16(Bt[n][k], At[m][k], acc[ai][bj][m][n], 0, 0, 0); __builtin_amdgcn_s_setprio(0); } while (0)
#define PG8_WAIT_V(n) asm volatile("s_waitcnt vmcnt(" #n ")" ::: "memory")
#define PG8_WAIT_L(n) asm volatile("s_waitcnt lgkmcnt(" #n ")" ::: "memory")
#define PG8_BAR __builtin_amdgcn_s_barrier()
#define PG8_SCHED __builtin_amdgcn_sched_barrier(0)
    Unit cur, nxt; int ui = 0;
    if (!S.next(0, cur)) return;
    f32x4 acc[2][2][4][2];
#pragma unroll
    for (int a = 0; a < 2; ++a)
#pragma unroll
        for (int b = 0; b < 2; ++b)
#pragma unroll
            for (int m = 0; m < 4; ++m)
#pragma unroll
                for (int n = 0; n < 2; ++n) acc[a][b][m][n] = (f32x4){0.f, 0.f, 0.f, 0.f};
    bf16x8 At[4][2], B0[2][2], B1[2][2];
    const char* cA = (const char*)g.A + (size_t)cur.pm * tstep; const char* cB = (const char*)g.Bt + (size_t)cur.pn * tstep;
    S.a_ready(cur);
    if constexpr (SP2) {
        PG8_STAGE(PG8_SB(0, 0), cB, voffB); PG8_STAGE(PG8_SB(0, 1), cB + hstep, voffB); PG8_STAGE(PG8_SA(0, 0), cA, voffA); PG8_STAGE(PG8_SA(0, 1), cA + hstep, voffA);
        if (wr == 1) PG8_BAR;
        PG8_WAIT_V(2); PG8_BAR;
        PG8_STAGE(PG8_SB(1, 0), cB + kstep, voffB); PG8_STAGE(PG8_SA(1, 0), cA + kstep, voffA); PG8_STAGE(PG8_SB(1, 1), cB + hstep + kstep, voffB);
        PG8_WAIT_V(6); PG8_BAR;
    } else {
        PG8_STAGE(PG8_SB(0, 0), cB, voffB); PG8_STAGE(PG8_SA(0, 0), cA, voffA); PG8_STAGE(PG8_SB(0, 1), cB + hstep, voffB); PG8_STAGE(PG8_SA(0, 1), cA + hstep, voffA);
        if (wr == 1) PG8_BAR;
        PG8_WAIT_V(4); PG8_BAR;
        PG8_STAGE(PG8_SB(1, 0), cB + kstep, voffB); PG8_STAGE(PG8_SA(1, 0), cA + kstep, voffA); PG8_STAGE(PG8_SB(1, 1), cB + hstep + kstep, voffB);
        PG8_WAIT_V(6); PG8_BAR;
    }
    for (;;) {
        const bool has_next = S.next(ui + 1, nxt);
        const char* nA = has_next ? (const char*)g.A + (size_t)nxt.pm * tstep : cA; const char* nB = has_next ? (const char*)g.Bt + (size_t)nxt.pn * tstep : cB;
        for (int t = 0; t < nt; t += 2) {
            const bool last = (t == nt - 2);
            const char* a1 = cA + (size_t)(t + 1) * kstep;
            const char* a2 = last ? nA : cA + (size_t)(t + 2) * kstep; const char* b2 = last ? nB : cB + (size_t)(t + 2) * kstep;
            const char* a3 = a2 + kstep; const char* b3 = b2 + kstep;
            if (last && has_next) S.a_ready(nxt);
            if constexpr (SP2) {
            PG8_LDB(B0, 0, 0); PG8_LDB(B1, 0, 1); PG8_SCHED; PG8_LDA(At, 0, 0); PG8_STAGE(PG8_SA(1, 1), a1 + hstep, voffA);
            PG8_WAIT_V(8); PG8_WAIT_L(0); PG8_BAR; PG8_MMA(0, 0, At, B0); PG8_MMA(0, 1, At, B1); PG8_BAR; PG8_SCHED;
            PG8_LDA(At, 0, 1); PG8_STAGE(PG8_SB(0, 0), b2, voffB); PG8_STAGE(PG8_SB(0, 1), b2 + hstep, voffB); PG8_STAGE(PG8_SA(0, 0), a2, voffA);
            PG8_WAIT_V(8); PG8_WAIT_L(0); PG8_BAR; PG8_MMA(1, 0, At, B0); PG8_MMA(1, 1, At, B1); PG8_BAR; PG8_SCHED;
            PG8_LDB(B0, 1, 0); PG8_LDB(B1, 1, 1); PG8_SCHED; PG8_LDA(At, 1, 0); PG8_STAGE(PG8_SA(0, 1), a2 + hstep, voffA);
            PG8_WAIT_V(8); PG8_WAIT_L(0); PG8_BAR; PG8_MMA(0, 0, At, B0); PG8_MMA(0, 1, At, B1); PG8_BAR; PG8_SCHED;
            PG8_LDA(At, 1, 1); PG8_STAGE(PG8_SB(1, 0), b3, voffB); PG8_STAGE(PG8_SB(1, 1), b3 + hstep, voffB); PG8_STAGE(PG8_SA(1, 0), a3, voffA);
            PG8_WAIT_V(8); PG8_WAIT_L(0); PG8_BAR; PG8_MMA(1, 0, At, B0); PG8_MMA(1, 1, At, B1); PG8_BAR; PG8_SCHED;
            } else {
            PG8_LDB(B0, 0, 0); PG8_SCHED; PG8_LDA(At, 0, 0); PG8_STAGE(PG8_SA(1, 1), a1 + hstep, voffA);
            PG8_WAIT_L(8); PG8_BAR; PG8_WAIT_L(0); PG8_MMA(0, 0, At, B0); PG8_BAR; PG8_SCHED;
            PG8_LDB(B1, 0, 1); PG8_STAGE(PG8_SB(0, 0), b2, voffB);
            PG8_BAR; PG8_WAIT_L(0); PG8_MMA(0, 1, At, B1); PG8_BAR;
            PG8_LDA(At, 0, 1); PG8_STAGE(PG8_SA(0, 0), a2, voffA);
            PG8_BAR; PG8_WAIT_L(0); PG8_MMA(1, 0, At, B0); PG8_BAR; PG8_SCHED;
            PG8_STAGE(PG8_SB(0, 1), b2 + hstep, voffB);
            PG8_WAIT_V(6); PG8_BAR; PG8_MMA(1, 1, At, B1); PG8_BAR;
            PG8_LDB(B0, 1, 0); PG8_SCHED; PG8_LDA(At, 1, 0); PG8_STAGE(PG8_SA(0, 1), a2 + hstep, voffA);
            PG8_WAIT_L(8); PG8_BAR; PG8_WAIT_L(0); PG8_MMA(0, 0, At, B0); PG8_BAR; PG8_SCHED;
            PG8_LDB(B1, 1, 1); PG8_STAGE(PG8_SB(1, 0), b3, voffB);
            PG8_BAR; PG8_WAIT_L(0); PG8_MMA(0, 1, At, B1); PG8_BAR;
            PG8_LDA(At, 1, 1); PG8_STAGE(PG8_SA(1, 0), a3, voffA);
            PG8_BAR; PG8_WAIT_L(0); PG8_MMA(1, 0, At, B0); PG8_BAR; PG8_SCHED;
            PG8_STAGE(PG8_SB(1, 1), b3 + hstep, voffB);
            PG8_WAIT_V(6); PG8_BAR; PG8_MMA(1, 1, At, B1); PG8_BAR;
            }
        }
        if constexpr (ALIGN_EPI) { if (wr == 0) PG8_BAR; }
        if constexpr (!Epi::AFTER_DRAIN) { E(acc, cur, wr, wc, fr, fq); S.done(cur); }
        if (!has_next) break;
#pragma unroll
        for (int a = 0; a < 2; ++a)
#pragma unroll
            for (int b = 0; b < 2; ++b)
#pragma unroll
                for (int m = 0; m < 4; ++m)
#pragma unroll
                    for (int n = 0; n < 2; ++n) acc[a][b][m][n] = (f32x4){0.f, 0.f, 0.f, 0.f};
        cur = nxt; cA = nA; cB = nB; ++ui;
        if constexpr (ALIGN_EPI) { if (wr == 1) PG8_BAR; }
    }
    PG8_WAIT_V(0);
    if constexpr (!ALIGN_EPI) { if (wr == 0) PG8_BAR; }
    PG8_BAR;
    if constexpr (Epi::AFTER_DRAIN) { E.fused(acc, cur, wr, wc, fr, fq, lds, wid, lane); S.done(cur); }
#undef PG8_SA
#undef PG8_SB
#undef PG8_STAGE
#undef PG8_LDA
#undef PG8_LDB
#undef PG8_MMA
#undef PG8_WAIT_V
#undef PG8_WAIT_L
#undef PG8_BAR
#undef PG8_SCHED
}
}
#define LAS __attribute__((address_space(3)))
#define DI_ __device__ __forceinline__
typedef unsigned short bf16_t;
typedef short bf16x8 __attribute__((ext_vector_type(8)));
typedef float f32x4 __attribute__((ext_vector_type(4)));
typedef float f32x2 __attribute__((ext_vector_type(2)));
typedef float f32x16 __attribute__((ext_vector_type(16)));
typedef unsigned u32x4 __attribute__((ext_vector_type(4)));
typedef unsigned u32x2 __attribute__((ext_vector_type(2)));
typedef __bf16 hbf2 __attribute__((ext_vector_type(2)));

constexpr int T = 16384, DM = 1024, DI = 2048, SEQ = 4096, NB = 4, NH = 16;
constexpr float EPS = 1e-6f;
constexpr float LOG2E = 1.4426950408889634f, LN2 = 0.6931471805599453f;
constexpr size_t MiB = 1u << 20;
constexpr size_t WS_WB = 1 * MiB, WS_H = 22 * MiB, WS_Q = 54 * MiB, WS_K = 118 * MiB, WS_VT = 182 * MiB, WS_CS = 246 * MiB, WS_LF = 250 * MiB, WS_CUM = 251 * MiB, WS_END = 252 * MiB;
constexpr size_t WS_O = WS_Q, WS_LAT = WS_Q, WS_QG = 118 * MiB  , WS_KL = 214 * MiB  , WS_KVNT = 220 * MiB  , WS_QN = 228 * MiB, WS_KVN = 236 * MiB;
constexpr size_t WB_IN = 0, WB_O = (size_t)8192 * 1024;
constexpr size_t WB1_LAT = 0, WB1_G = (size_t)448 * 1024  , WB1_Q = WB1_G + (size_t)2048 * 1024, WB1_K = WB1_Q + (size_t)3072 * 256, WB1_V = WB1_K + (size_t)2048 * 128, WB1_O = WB1_V + (size_t)2048 * 128;
constexpr int LDS_CTL_OFF = 147456, LDS_BYTES = LDS_CTL_OFF + 1024;
constexpr int NPH = 23;

DI_ unsigned pk2(float a, float b) { f32x2 v = {a, b}; hbf2 r = __builtin_convertvector(v, hbf2); return __builtin_bit_cast(unsigned, r); }
DI_ float bf_lo(unsigned u) { return __uint_as_float(u << 16); }
DI_ float bf_hi(unsigned u) { return __uint_as_float(u & 0xffff0000u); }
DI_ float wave_sum(float v) {
#pragma unroll
    for (int o = 1; o < 64; o <<= 1) v += __shfl_xor(v, o);
    return v;
}
DI_ float silu_f(float x) { return x * __builtin_amdgcn_rcpf(1.0f + __builtin_amdgcn_exp2f(-x * LOG2E)); }
#define LDS_WAIT() asm volatile("s_waitcnt lgkmcnt(0)" ::: "memory")

namespace pg8 {
struct EpiBf16K {
    static constexpr bool PERM = true, AFTER_DRAIN = false;
    bf16_t* O; int ldc; int split_cols; size_t split_stride; float* knp;
    __device__ __forceinline__ void operator()(const f32x4 (&acc)[2][2][4][2], const Unit& u, int wr, int wc, int fr, int fq) const {
        const int row0 = u.pm * BM + wr * 64 + fr; int colt = u.pn * BM; bf16_t* base = O; int t = 0;
        if (split_cols) { t = colt / split_cols; base += (size_t)t * split_stride; colt -= t * split_cols; }
        const int col0 = colt + wc * 32 + 8 * fq;
        const bool kn = knp != nullptr && t == 1;
#pragma unroll
        for (int ai = 0; ai < 2; ++ai)
#pragma unroll
            for (int m = 0; m < 4; ++m) { const int row = row0 + ai * HALF + m * 16; bf16_t* rowp = base + (size_t)row * ldc + col0;
#pragma unroll
                for (int bj = 0; bj < 2; ++bj) { const f32x4 v0 = acc[ai][bj][m][0], v1 = acc[ai][bj][m][1];
                    u32x4 w; w.x = ::pk2(v0[0], v0[1]); w.y = ::pk2(v0[2], v0[3]); w.z = ::pk2(v1[0], v1[1]); w.w = ::pk2(v1[2], v1[3]);
                    *(u32x4*)(rowp + bj * HALF) = w;
                    if (kn) { float ss = ((v0[0] * v0[0] + v0[1] * v0[1]) + (v0[2] * v0[2] + v0[3] * v0[3])) + ((v1[0] * v1[0] + v1[1] * v1[1]) + (v1[2] * v1[2] + v1[3] * v1[3]));
                        ss += __shfl_xor(ss, 16); ss += __shfl_xor(ss, 32);
                        if (fq == 0) knp[((size_t)((row >> 12) * 16 + (colt >> 7) + bj) * 4096 + (row & 4095)) * 4 + wc] = ss; } } }
    }
};
struct EpiGate {
    static constexpr bool PERM = true, AFTER_DRAIN = false;
    bf16_t* O; int ldc;
    __device__ __forceinline__ void operator()(const f32x4 (&acc)[2][2][4][2], const Unit& u, int wr, int wc, int fr, int fq) const {
        const int row0 = u.pm * BM + wr * 64 + fr, col0 = u.pn * BM + wc * 32 + 8 * fq;
#pragma unroll
        for (int ai = 0; ai < 2; ++ai)
#pragma unroll
            for (int m = 0; m < 4; ++m) { bf16_t* rowp = O + (size_t)(row0 + ai * HALF + m * 16) * ldc + col0;
#pragma unroll
                for (int bj = 0; bj < 2; ++bj) { const f32x4 v0 = acc[ai][bj][m][0], v1 = acc[ai][bj][m][1];
                    const u32x4 ov = *(const u32x4*)(rowp + bj * HALF); u32x4 w;
                    w.x = ::pk2(::bf_lo(ov.x) * ::silu_f(v0[0]), ::bf_hi(ov.x) * ::silu_f(v0[1]));
                    w.y = ::pk2(::bf_lo(ov.y) * ::silu_f(v0[2]), ::bf_hi(ov.y) * ::silu_f(v0[3]));
                    w.z = ::pk2(::bf_lo(ov.z) * ::silu_f(v1[0]), ::bf_hi(ov.z) * ::silu_f(v1[1]));
                    w.w = ::pk2(::bf_lo(ov.w) * ::silu_f(v1[2]), ::bf_hi(ov.w) * ::silu_f(v1[3]));
                    *(u32x4*)(rowp + bj * HALF) = w; } }
    }
};
template <bool HASBASE> struct EpiF32 {
    static constexpr bool PERM = false, AFTER_DRAIN = false;
    const float* base; float* out; int ldc;
    __device__ __forceinline__ void operator()(const f32x4 (&acc)[2][2][4][2], const Unit& u, int wr, int wc, int fr, int fq) const {
        const int row0 = u.pm * BM + wr * 64 + fr, col0 = u.pn * BM + wc * 32 + 4 * fq;
#pragma unroll
        for (int ai = 0; ai < 2; ++ai)
#pragma unroll
            for (int m = 0; m < 4; ++m) { const size_t off = (size_t)(row0 + ai * HALF + m * 16) * ldc + col0;
#pragma unroll
                for (int bj = 0; bj < 2; ++bj)
#pragma unroll
                    for (int n = 0; n < 2; ++n) { f32x4 v = acc[ai][bj][m][n]; if constexpr (HASBASE) v += *(const f32x4*)(base + off + bj * HALF + n * 16); *(f32x4*)(out + off + bj * HALF + n * 16) = v; } }
    }
};
}

DI_ void tr_item(const float* W, int ldw, int K, int k0, int col0, bf16_t* WT, int row0, LAS float* scr, int lane) {
#pragma unroll 8
    for (int i = 0; i < 32; ++i) { const int kk = 2 * i + (lane >> 5); scr[kk * 33 + (lane & 31)] = W[(size_t)(k0 + kk) * ldw + col0 + (lane & 31)]; }
    LDS_WAIT();
    const int c = lane & 7;
#pragma unroll
    for (int j = 0; j < 4; ++j) { const int n = (lane >> 3) + 8 * j; const LAS float* s = scr + (8 * c) * 33 + n;
        u32x4 o; o.x = pk2(s[0 * 33], s[1 * 33]); o.y = pk2(s[2 * 33], s[3 * 33]); o.z = pk2(s[4 * 33], s[5 * 33]); o.w = pk2(s[6 * 33], s[7 * 33]);
        *(u32x4*)(WT + (size_t)(row0 + n) * K + k0 + 8 * c) = o; }
    LDS_WAIT();
}
DI_ void conv_seg(const float* W, int ldw, int K, int col_start, int ncols, bf16_t* WT, int row_start, LAS float* scr, int gw, int NGW, int lane) {
    const int nblk = ncols / 32, nitems = (K / 64) * nblk;
    for (int it = gw; it < nitems; it += NGW) { const int kb = it / nblk, nb = it - kb * nblk; tr_item(W, ldw, K, 64 * kb, col_start + 32 * nb, WT, row_start + 32 * nb, scr, lane); }
}
#define XB_TMO      128
#define XB_XCNT(j)  (256  + 64 * (j))
#define XB_XSUB(j)  (1280 + 64 * (j))
#define XB_XGEN(j)  (2304 + 64 * (j))
#define XB_TOP      3328
#define XB_TOPGEN   3392
#define XCD_BAR_WORDS 3456
#define XB_SPIN_CAP (1u << 18)

__device__ __forceinline__ unsigned xb_ld(unsigned* p)              { return __hip_atomic_load(p, __ATOMIC_RELAXED, __HIP_MEMORY_SCOPE_AGENT); }
__device__ __forceinline__ unsigned xb_add(unsigned* p, unsigned v) { return __hip_atomic_fetch_add(p, v, __ATOMIC_RELAXED, __HIP_MEMORY_SCOPE_AGENT); }
__device__ __forceinline__ unsigned xb_xcc_id() { return (unsigned)__builtin_amdgcn_s_getreg((3 << 11) | 20) & 0xFu; }
#define XB_SPIN(cond, bar) do { unsigned _sp = 0; while (cond) { __builtin_amdgcn_s_sleep(1); \
    if ((++_sp & 255u) == 0u) { if (xb_ld(&(bar)[XB_TMO])) break; if (_sp > XB_SPIN_CAP) { atomicAdd(&(bar)[XB_TMO], 1u); break; } } } } while (0)

struct XcdBarrier {
    unsigned* bar; unsigned x;
    volatile LAS unsigned* st;
};

__device__ __forceinline__ XcdBarrier xcd_barrier_post(unsigned* bar, volatile LAS unsigned* st) {
    XcdBarrier b; b.bar = bar; b.x = xb_xcc_id(); b.st = st;
    if (threadIdx.x == 0) (void)xb_add(&bar[XB_XCNT(b.x)], 1u);
    return b;
}
__device__ __forceinline__ void xcd_barrier_complete(unsigned* bar, unsigned x, unsigned& nloc, unsigned& nx) {
    const unsigned G = gridDim.x * gridDim.y * gridDim.z;
    unsigned sum, cnt, mine, sp = 0u;
    for (;;) {
        sum = 0u; cnt = 0u; mine = 0u;
#pragma unroll
        for (unsigned j = 0; j < 16; ++j) { const unsigned c = xb_ld(&bar[XB_XCNT(j)]); sum += c; cnt += (c > 0u) ? 1u : 0u; mine = (j == x) ? c : mine; }
        if (sum == G) break;
        __builtin_amdgcn_s_sleep(1);
        if ((++sp & 255u) == 0u) { if (xb_ld(&bar[XB_TMO])) break; if (sp > XB_SPIN_CAP) { atomicAdd(&bar[XB_TMO], 1u); break; } }
    }
    nloc = mine > 0u ? mine : 1u; nx = cnt > 0u ? cnt : 1u;
}

__device__ __forceinline__ void xcd_barrier(const XcdBarrier& b) {
    asm volatile("s_waitcnt vmcnt(0)" ::: "memory");
    __syncthreads();
    if (threadIdx.x == 0) {
        unsigned* bar = b.bar;
        __builtin_amdgcn_s_waitcnt(0);
        unsigned nloc = b.st[0], nx = b.st[1];
        if (nloc == 0u) { xcd_barrier_complete(bar, b.x, nloc, nx); b.st[0] = nloc; b.st[1] = nx; }
        const unsigned old = xb_add(&bar[XB_XSUB(b.x)], 1u);
        const unsigned gen = old / nloc;
        if (old + 1u == (gen + 1u) * nloc) {
            __builtin_amdgcn_fence(__ATOMIC_RELEASE, "agent");
            asm volatile("s_waitcnt vmcnt(0)" ::: "memory");
            const unsigned og = xb_add(&bar[XB_TOP], 1u);
            const unsigned tg = og / nx;
            if (og + 1u == (tg + 1u) * nx) xb_add(&bar[XB_TOPGEN], 1u);
            else XB_SPIN(xb_ld(&bar[XB_TOPGEN]) == tg, bar);
            __builtin_amdgcn_fence(__ATOMIC_ACQUIRE, "agent");
            xb_add(&bar[XB_XGEN(b.x)], 1u);
            asm volatile("s_waitcnt vmcnt(0)" ::: "memory");
        } else {
            XB_SPIN(xb_ld(&bar[XB_XGEN(b.x)]) == gen, bar);
            __builtin_amdgcn_fence(__ATOMIC_ACQUIRE, "agent");
            asm volatile("s_waitcnt vmcnt(0)" ::: "memory");
        }
    }
    __syncthreads();
}
struct AttnP { const bf16_t* Q; const bf16_t* K; const bf16_t* KR; const bf16_t* VT; bf16_t* O; const float* cum; const float* cs; const float* kn2; const bf16_t* WV; int qpitch, kpitch, opitch, nh, khead, krpitch, vheadrows; };
#define MFMA32(a, b, c) __builtin_amdgcn_mfma_f32_32x32x16_bf16((a), (b), (c), 0, 0, 0)
DI_ bf16x8 pack8(float a0, float a1, float a2, float a3, float a4, float a5, float a6, float a7) {
    u32x4 w = {pk2(a0, a1), pk2(a2, a3), pk2(a4, a5), pk2(a6, a7)}; return __builtin_bit_cast(bf16x8, w);
}
DI_ float xhalf(float x) { const auto r = __builtin_amdgcn_permlane32_swap(__float_as_uint(x), __float_as_uint(x), false, false); return __uint_as_float((threadIdx.x & 32) ? r[0] : r[1]); }

DI_ void stick_half(f32x16& p, float& R, const bool diag, const int dqh, const int hi, const float C2) {
    float ls[16];
    if (diag) {
#pragma unroll
        for (int r = 0; r < 16; ++r) { const int kk = (r & 3) + 8 * (r >> 2) + 4 * hi; if (!(kk < dqh)) p[r] = -__builtin_inff(); }
    }
#pragma unroll
    for (int r = 0; r < 16; ++r) { const float z = __builtin_amdgcn_fmed3f(p[r] * C2, -150.f, 126.f), sp = __builtin_amdgcn_logf(1.0f + __builtin_amdgcn_exp2f(z)); ls[r] = -sp; p[r] = z - sp; }
    float gs[4], ps[4], tot[4];
#pragma unroll
    for (int g = 0; g < 4; ++g) { gs[g] = (ls[4 * g] + ls[4 * g + 1]) + (ls[4 * g + 2] + ls[4 * g + 3]); ps[g] = xhalf(gs[g]); tot[g] = gs[g] + ps[g]; }
    float suf = 0.f;
#pragma unroll
    for (int g = 3; g >= 0; --g) {
        const float l3 = R + suf + (hi == 0 ? ps[g] : 0.f), l2 = l3 + ls[4 * g + 3], l1 = l2 + ls[4 * g + 2], l0 = l1 + ls[4 * g + 1];
        p[4 * g + 3] = __builtin_amdgcn_exp2f(p[4 * g + 3] + l3); p[4 * g + 2] = __builtin_amdgcn_exp2f(p[4 * g + 2] + l2);
        p[4 * g + 1] = __builtin_amdgcn_exp2f(p[4 * g + 1] + l1); p[4 * g] = __builtin_amdgcn_exp2f(p[4 * g] + l0);
        suf += tot[g];
    }
    R += suf;
}

template <int MODE>
DI_ void attn_unit(LAS unsigned char* lds, const AttnP& P, const int b, const int hh, const int qb) {
    constexpr int DK = MODE == 1 ? 192 : 128, NKS = DK / 16, KROW = DK * 2, KT_BYTES = 64 * KROW, VSTR = 144, VT_BYTES = 128 * VSTR;
    constexpr int CT_OFF = KT_BYTES + VT_BYTES, BUF = CT_OFF + 256, FLAG_OFF = 2 * BUF;
    int tid_ = threadIdx.x; asm volatile("" : "+v"(tid_));
    const int tid = tid_, wid = __builtin_amdgcn_readfirstlane(tid >> 6), lane = tid & 63, r32 = lane & 31, hi = lane >> 5;
    const int q0 = qb * 256, tq = q0 + wid * 32 + r32;
    const size_t tokq = (size_t)b * SEQ + tq;
    constexpr float SCALE = MODE == 1 ? 0.07216878364870322f : 0.08838834764831845f;
    constexpr float C2 = SCALE * LOG2E;
    bf16x8 qr[NKS];
    { const bf16_t* qp = P.Q + tokq * P.qpitch + hh * DK + hi * 8;
#pragma unroll
      for (int d0 = 0; d0 < NKS; ++d0) qr[d0] = *(const bf16x8*)(qp + d0 * 16); }
    if constexpr (MODE == 1) {
#pragma unroll
        for (int dd = 0; dd < 2; ++dd) {
            const float* cp = P.cs + tokq * 32 + 16 * dd + 8 * hi; const float* sp = cp + (size_t)T * 32;
            const f32x4 c0 = *(const f32x4*)cp, c1 = *(const f32x4*)(cp + 4), s0 = *(const f32x4*)sp, s1 = *(const f32x4*)(sp + 4);
            const u32x4 a = __builtin_bit_cast(u32x4, qr[8 + dd]), bb = __builtin_bit_cast(u32x4, qr[10 + dd]);
            float x1[8] = {bf_lo(a.x), bf_hi(a.x), bf_lo(a.y), bf_hi(a.y), bf_lo(a.z), bf_hi(a.z), bf_lo(a.w), bf_hi(a.w)};
            float x2[8] = {bf_lo(bb.x), bf_hi(bb.x), bf_lo(bb.y), bf_hi(bb.y), bf_lo(bb.z), bf_hi(bb.z), bf_lo(bb.w), bf_hi(bb.w)};
            float cc[8] = {c0[0], c0[1], c0[2], c0[3], c1[0], c1[1], c1[2], c1[3]}, ss[8] = {s0[0], s0[1], s0[2], s0[3], s1[0], s1[1], s1[2], s1[3]};
            float y1[8], y2[8];
#pragma unroll
            for (int i = 0; i < 8; ++i) { y1[i] = x1[i] * cc[i] - x2[i] * ss[i]; y2[i] = x1[i] * ss[i] + x2[i] * cc[i]; }
            qr[8 + dd] = pack8(y1[0], y1[1], y1[2], y1[3], y1[4], y1[5], y1[6], y1[7]);
            qr[10 + dd] = pack8(y2[0], y2[1], y2[2], y2[3], y2[4], y2[5], y2[6], y2[7]);
        }
    }
    const bf16_t* Kg = P.K + (size_t)b * SEQ * P.kpitch + hh * P.khead;
    const bf16_t* VTg = P.VT + (size_t)(hh * P.vheadrows) * T + (size_t)b * SEQ;
    const int krow = tid >> 4, kc = tid & 15;
    const int ksw = MODE == 1 ? krow * KROW + ((kc ^ ((((krow >> 1) & 1) << 2) | ((krow >> 2) & 3))) << 4) : krow * KROW + ((kc ^ (krow & 15)) << 4);
    const int rrow = tid >> 3, rc = tid & 7;
    const int rsw = rrow * KROW + (((16 + rc) ^ ((((rrow >> 1) & 1) << 2) | ((rrow >> 2) & 3))) << 4);
    const int vrow = tid >> 3, vc = tid & 7;
    const int vsw = KT_BYTES + vrow * VSTR + (vc >> 1) * 32 + (vc & 1) * 8;
    const int kfb = MODE == 1 ? r32 * KROW : r32 * KROW + ((hi ^ (r32 & 15)) << 4);
    const int kg16 = (hi ^ ((((r32 >> 1) & 1) << 2) | ((r32 >> 2) & 3))) << 4;
    const int vfb = KT_BYTES + r32 * VSTR + hi * 16;
    float m_run = -1e30f, l_run = 0.f, R = 0.f;
    f32x16 o[4];
#pragma unroll
    for (int d = 0; d < 4; ++d)
#pragma unroll
        for (int r = 0; r < 16; ++r) o[d][r] = 0.f;
    const int jd = (q0 >> 6) + (wid >> 1), jtop = (q0 >> 6) + 3;
    const int dq = (wid & 1) * 32 + r32;
    constexpr bool DESC = MODE != 1;
    int j = DESC ? jtop : 0;
    bf16x8 sk0, sk1, skr, sv0, sv1; float scv = 0.f;
#define A_GLOAD(jj) do { const bf16_t* kp = Kg + (size_t)((jj) * 64 + krow) * P.kpitch + kc * 8; sk0 = *(const bf16x8*)kp; sk1 = *(const bf16x8*)(kp + (size_t)32 * P.kpitch); \
        if constexpr (MODE == 1) skr = *(const bf16x8*)(P.KR + ((size_t)b * SEQ + (jj) * 64 + rrow) * P.krpitch + rc * 8); \
        if constexpr (MODE != 1) { const bf16_t* vp = VTg + (size_t)vrow * T + (jj) * 64 + vc * 8; sv0 = *(const bf16x8*)vp; sv1 = *(const bf16x8*)(vp + (size_t)64 * T); } \
        if constexpr (MODE == 2) { if (tid < 64) scv = P.cum[((size_t)b * NH + hh) * SEQ + (jj) * 64 + tid]; } } while (0)
#define A_SWRITE(bufi) do { LAS unsigned char* bp = lds + (bufi) * BUF; *(LAS bf16x8*)(bp + ksw) = sk0; *(LAS bf16x8*)(bp + ksw + 32 * KROW) = sk1; \
        if constexpr (MODE == 1) *(LAS bf16x8*)(bp + rsw) = skr; \
        if constexpr (MODE != 1) { const u32x4 a = __builtin_bit_cast(u32x4, sv0), c = __builtin_bit_cast(u32x4, sv1); \
          *(LAS u32x2*)(bp + vsw) = (u32x2){a.x, a.y}; *(LAS u32x2*)(bp + vsw + 16) = (u32x2){a.z, a.w}; \
          *(LAS u32x2*)(bp + vsw + 64 * VSTR) = (u32x2){c.x, c.y}; *(LAS u32x2*)(bp + vsw + 64 * VSTR + 16) = (u32x2){c.z, c.w}; } \
        if constexpr (MODE == 2) { if (tid < 64) *(LAS float*)(bp + CT_OFF + tid * 4) = scv; } } while (0)
    float bound_t = 0.f;
    if constexpr (MODE != 0) {
        float km = 0.f;
        if constexpr (MODE == 2) { const f32x4* kn = (const f32x4*)P.kn2 + ((size_t)b * NH + hh) * SEQ;
            for (int i = tid; i < q0 + 256; i += 512) { const f32x4 v = kn[i]; km = fmaxf(km, (v.x + v.y) + (v.z + v.w)); } }
        else { const float* kn = P.kn2 + (size_t)b * SEQ;
            for (int i = tid; i < q0 + 256; i += 512) km = fmaxf(km, kn[i]); }
#pragma unroll
        for (int o_ = 1; o_ < 64; o_ <<= 1) km = fmaxf(km, __shfl_xor(km, o_));
        if (lane == 0) *(LAS float*)(lds + FLAG_OFF + 64 + wid * 4) = km;
        float q2 = 0.f;
#pragma unroll
        for (int d0 = 0; d0 < NKS; ++d0) { const u32x4 a = __builtin_bit_cast(u32x4, qr[d0]);
            q2 += (bf_lo(a.x) * bf_lo(a.x) + bf_hi(a.x) * bf_hi(a.x)) + (bf_lo(a.y) * bf_lo(a.y) + bf_hi(a.y) * bf_hi(a.y)) + (bf_lo(a.z) * bf_lo(a.z) + bf_hi(a.z) * bf_hi(a.z)) + (bf_lo(a.w) * bf_lo(a.w) + bf_hi(a.w) * bf_hi(a.w)); }
        q2 += xhalf(q2);
        bound_t = q2;
    }
    A_GLOAD(j); A_SWRITE(0);
    if (DESC ? (j > 0) : (j < jtop)) A_GLOAD(DESC ? j - 1 : j + 1);
    __syncthreads();
    if constexpr (MODE != 0) { const f32x4 k0 = *(const LAS f32x4*)(lds + FLAG_OFF + 64), k1 = *(const LAS f32x4*)(lds + FLAG_OFF + 80);
        const float km2 = fmaxf(fmaxf(fmaxf(k0.x, k0.y), fmaxf(k0.z, k0.w)), fmaxf(fmaxf(k1.x, k1.y), fmaxf(k1.z, k1.w)));
        bound_t = sqrtf(bound_t * km2) * (C2 * 1.02f); }
    float nck_t = 0.f;
    if constexpr (MODE == 2) nck_t = P.cum[((size_t)b * NH + hh) * SEQ + tq];
    bool wdone = false;
    for (int it = 0;; ++it) {
        const int cur = it & 1;
        const int jn = DESC ? j - 1 : j + 1;
        const bool pre = DESC ? (j > 0) : (j < jtop);
        const bool act = (j <= jd) && !wdone;
        if (act) {
            const LAS unsigned char* bp = lds + cur * BUF;
            f32x16 p0, p1;
#pragma unroll
            for (int r = 0; r < 16; ++r) { p0[r] = 0.f; p1[r] = 0.f; }
            {
                bf16x8 kf[3][2];
#define A_KLD(d0_) do { const int ka_ = MODE == 1 ? kfb + (((d0_) << 5) ^ kg16) : (kfb ^ ((d0_) << 5)); kf[(d0_) % 3][0] = *(const LAS bf16x8*)(bp + ka_); kf[(d0_) % 3][1] = *(const LAS bf16x8*)(bp + ka_ + 32 * KROW); } while (0)
                A_KLD(0); A_KLD(1);
#pragma unroll
                for (int d0 = 0; d0 < NKS; ++d0) {
                    if (d0 + 2 < NKS) A_KLD(d0 + 2);
                    p0 = MFMA32(kf[d0 % 3][0], qr[d0], p0); p1 = MFMA32(kf[d0 % 3][1], qr[d0], p1);
                }
#undef A_KLD
                __builtin_amdgcn_sched_group_barrier(0x100, 4, 0);
#pragma unroll
                for (int d0 = 0; d0 < NKS - 2; ++d0) { __builtin_amdgcn_sched_group_barrier(0x100, 2, 0); __builtin_amdgcn_sched_group_barrier(0x008, 2, 0); }
                __builtin_amdgcn_sched_group_barrier(0x008, 4, 0);
            }
            const bool diag = (j == jd);
            if constexpr (MODE == 0) {
                stick_half(p1, R, diag, dq - 32, hi, C2);
                __builtin_amdgcn_sched_barrier(0);
                stick_half(p0, R, diag, dq, hi, C2);
                wdone = __all(R < -46.0f) != 0;
            } else {
                if constexpr (MODE == 2) {
#pragma unroll
                    for (int g = 0; g < 4; ++g) {
                        const f32x4 ck0 = *(const LAS f32x4*)(bp + CT_OFF + g * 32 + hi * 16), ck1 = *(const LAS f32x4*)(bp + CT_OFF + 128 + g * 32 + hi * 16);
#pragma unroll
                        for (int e = 0; e < 4; ++e) { const int r = 4 * g + e, kk = 8 * g + 4 * hi + e;
                            float y0 = fmaf(p0[r], C2, ck0[e]), y1 = fmaf(p1[r], C2, ck1[e]);
                            if (diag) { if (kk > dq) y0 = -__builtin_inff(); if (kk + 32 > dq) y1 = -__builtin_inff(); }
                            p0[r] = y0; p1[r] = y1; }
                    }
                }
                if constexpr (MODE == 2) m_run = bound_t + nck_t;
                if constexpr (MODE != 0) {
                    if constexpr (MODE == 1) m_run = bound_t;
                } else {
                float pmax = fmaxf(p0[0], p1[0]);
#pragma unroll
                for (int r = 1; r < 16; ++r) pmax = fmaxf(pmax, fmaxf(p0[r], p1[r]));
                pmax = fmaxf(pmax, xhalf(pmax));
                if (!__all(pmax - m_run <= 8.0f)) {
                    const float mn = fmaxf(m_run, pmax), alpha = __builtin_amdgcn_exp2f(m_run - mn);
                    m_run = mn; l_run *= alpha;
#pragma unroll
                    for (int d = 0; d < 4; ++d)
#pragma unroll
                        for (int r = 0; r < 16; ++r) o[d][r] *= alpha;
                }
                }
                float ps0 = 0.f, ps1 = 0.f;
#pragma unroll
                for (int r = 0; r < 16; ++r) {
                    if constexpr (MODE == 1) { p0[r] = __builtin_amdgcn_exp2f(fmaf(p0[r], C2, -m_run)); p1[r] = __builtin_amdgcn_exp2f(fmaf(p1[r], C2, -m_run)); }
                    else { p0[r] = __builtin_amdgcn_exp2f(p0[r] - m_run); p1[r] = __builtin_amdgcn_exp2f(p1[r] - m_run); }
                    ps0 += p0[r]; ps1 += p1[r]; }
                l_run += ps0 + ps1;
                if constexpr (MODE == 2) {
                    const float nck0 = *(const LAS float*)(bp + CT_OFF);
                    wdone = __all((nck0 - nck_t) - __builtin_amdgcn_logf(l_run + xhalf(l_run)) < -56.0f) != 0;
                }
            }
            bf16x8 pb[4];
            pb[0] = pack8(p0[0], p0[1], p0[2], p0[3], p0[4], p0[5], p0[6], p0[7]); pb[1] = pack8(p0[8], p0[9], p0[10], p0[11], p0[12], p0[13], p0[14], p0[15]);
            pb[2] = pack8(p1[0], p1[1], p1[2], p1[3], p1[4], p1[5], p1[6], p1[7]); pb[3] = pack8(p1[8], p1[9], p1[10], p1[11], p1[12], p1[13], p1[14], p1[15]);
            {
                bf16x8 vf[5];
                typedef short s16x4_ __attribute__((ext_vector_type(4)));
                const int trq = (lane & 15) >> 2, trp = lane & 3, trg = (lane >> 4) & 1, trqh = trq >> 1;
                const int trl0 = (((2 * trg + (trp >> 1)) ^ hi) << 4) | ((trp & 1) * 8), trl1 = (((2 * trg + (trp >> 1)) ^ hi ^ 2) << 4) | ((trp & 1) * 8);
                const int trE = (4 * hi + trq) * KROW + trqh * 64, trO = (4 * hi + trq) * KROW - trqh * 64;
#define A_VLD_TR(i_) do { const int cb_ = (((i_) & 1) ? trO : trE) + ((i_) >> 2) * 16 * KROW + ((i_) & 3) * 64; \
                    const s16x4_ t0_ = __builtin_amdgcn_ds_read_tr16_b64_v4i16((LAS s16x4_*)(bp + cb_ + trl0)); \
                    const s16x4_ t1_ = __builtin_amdgcn_ds_read_tr16_b64_v4i16((LAS s16x4_*)(bp + cb_ + 8 * KROW + trl1)); \
                    vf[(i_) % 5] = (bf16x8){t0_[0], t0_[1], t0_[2], t0_[3], t1_[0], t1_[1], t1_[2], t1_[3]}; } while (0)
#define A_VLD(i_) do { if constexpr (MODE == 1) A_VLD_TR(i_); else vf[(i_) % 5] = *(const LAS bf16x8*)(bp + vfb + ((i_) & 3) * 32 * VSTR + ((i_) >> 2) * 32); } while (0)
                A_VLD(0); A_VLD(1); A_VLD(2); A_VLD(3);
#pragma unroll
                for (int i = 0; i < 16; ++i) {
                    if (i + 4 < 16) A_VLD(i + 4);
                    o[i & 3] = MFMA32(vf[i % 5], pb[i >> 2], o[i & 3]);
                }
#undef A_VLD
#undef A_VLD_TR
                constexpr int RPF = MODE == 1 ? 2 : 1;
                __builtin_amdgcn_sched_group_barrier(0x100, 4 * RPF, 1);
#pragma unroll
                for (int i = 0; i < 12; ++i) { __builtin_amdgcn_sched_group_barrier(0x100, RPF, 1); __builtin_amdgcn_sched_group_barrier(0x008, 1, 1); }
                __builtin_amdgcn_sched_group_barrier(0x008, 4, 1);
            }
        }
        if constexpr (DESC) { if (lane == 0) *(LAS unsigned*)(lds + FLAG_OFF + (cur * 8 + wid) * 4) = wdone ? 1u : 0u; }
        if (pre) { A_SWRITE(cur ^ 1);
            const int jn2 = DESC ? jn - 1 : jn + 1; if (DESC ? (jn > 0) : (jn < jtop)) A_GLOAD(jn2); }
        __syncthreads();
        bool alldone = false;
        if constexpr (DESC) { const u32x4 f0 = *(const LAS u32x4*)(lds + FLAG_OFF + cur * 32), f1 = *(const LAS u32x4*)(lds + FLAG_OFF + cur * 32 + 16);
            alldone = (f0.x & f0.y & f0.z & f0.w & f1.x & f1.y & f1.z & f1.w) != 0u; }
        if (!pre || alldone) break;
        j = jn;
    }
#undef A_GLOAD
#undef A_SWRITE
    if constexpr (MODE != 0) { const float lt = l_run + xhalf(l_run), inv = 1.0f / lt;
#pragma unroll
        for (int d = 0; d < 4; ++d)
#pragma unroll
            for (int r = 0; r < 16; ++r) o[d][r] *= inv; }
    if constexpr (MODE == 1) {
        constexpr int WSTR = 272;
        { const bf16_t* wg = P.WV + (size_t)(hh * 128) * 128;
#pragma unroll
          for (int i = 0; i < 4; ++i) { const int id = tid + 512 * i, d = id >> 4, ch = id & 15; const u32x4 a = *(const u32x4*)(wg + (size_t)d * 128 + ch * 8);
              LAS unsigned char* wp = lds + d * WSTR + (ch >> 1) * 32 + (ch & 1) * 8; *(LAS u32x2*)wp = (u32x2){a.x, a.y}; *(LAS u32x2*)(wp + 16) = (u32x2){a.z, a.w}; } }
        bf16x8 ob[4][2];
#pragma unroll
        for (int cb = 0; cb < 4; ++cb) { ob[cb][0] = pack8(o[cb][0], o[cb][1], o[cb][2], o[cb][3], o[cb][4], o[cb][5], o[cb][6], o[cb][7]); ob[cb][1] = pack8(o[cb][8], o[cb][9], o[cb][10], o[cb][11], o[cb][12], o[cb][13], o[cb][14], o[cb][15]); }
        __syncthreads();
#pragma unroll
        for (int db = 0; db < 4; ++db) { f32x16 acc;
#pragma unroll
            for (int r = 0; r < 16; ++r) acc[r] = 0.f;
#pragma unroll
            for (int cb = 0; cb < 4; ++cb)
#pragma unroll
                for (int s = 0; s < 2; ++s) { const bf16x8 av = *(const LAS bf16x8*)(lds + (db * 32 + r32) * WSTR + (cb * 2 + s) * 32 + hi * 16); acc = MFMA32(av, ob[cb][s], acc); }
            o[db] = acc; }
        __syncthreads();
    }
    {
        constexpr int OSTR = 144, OST_OFF = 88 * 1024; static_assert(FLAG_OFF + 128 <= OST_OFF && OST_OFF + 8 * 32 * OSTR <= 131072, "O slab");
        LAS unsigned char* ob = lds + OST_OFF + wid * (32 * OSTR);
        bf16_t* og = P.O + ((size_t)b * SEQ + q0 + wid * 32) * P.opitch + hh * 128;
#pragma unroll
        for (int h = 0; h < 2; ++h) {
#pragma unroll
            for (int dd = 0; dd < 2; ++dd)
#pragma unroll
                for (int g = 0; g < 4; ++g) { const int d = 2 * h + dd;
                    *(LAS u32x2*)(ob + r32 * OSTR + (dd * 32 + 8 * g + 4 * hi) * 2) = (u32x2){pk2(o[d][4 * g], o[d][4 * g + 1]), pk2(o[d][4 * g + 2], o[d][4 * g + 3])}; }
            LDS_WAIT();
#pragma unroll
            for (int i = 0; i < 4; ++i) { const int row = 8 * i + (lane >> 3), ch = lane & 7;
                const u32x4 v = *(const LAS u32x4*)(ob + row * OSTR + ch * 16);
                *(u32x4*)(og + (size_t)row * P.opitch + h * 64 + ch * 8) = v; }
            LDS_WAIT();
        }
    }
}
DI_ void stick_wave_phase(LAS unsigned char* lds, const AttnP& P, const int gw, const int NGW) {
    constexpr int WSLAB = 18432, VOFF = 8192, VROW = 320;
    constexpr float C2 = 0.08838834764831845f * LOG2E;
    int tid_ = threadIdx.x; asm volatile("" : "+v"(tid_));
    const int wid = __builtin_amdgcn_readfirstlane(tid_ >> 6), lane = tid_ & 63, r32 = lane & 31, hi = lane >> 5;
    LAS unsigned char* wl = lds + wid * WSLAB;
    const int kfb = r32 * 256 + ((hi ^ (r32 & 15)) << 4);
    const int vfb = VOFF + (4 * hi + ((lane & 15) >> 2)) * VROW + ((lane >> 4) & 1) * 32 + (lane & 3) * 8;
#define SW_UNIT(w0_) ((NGW == 2048) ? (((16 * ((w0_) >> 11) + 2 * (((w0_) >> 3) & 7) + ((((w0_) >> 3 & 255) >> 3) >> 4)) << 7) + ((((w0_) >> 3 & 255) >> 3) & 15) * 8 + ((w0_) & 7)) : (w0_))
#define SW_QLOAD(wu_) do { const int bh_ = (wu_) >> 7, rb_ = (wu_) & 127; const bf16_t* qp = P.Q + ((size_t)(bh_ >> 4) * SEQ + 32 * rb_ + r32) * P.qpitch + (bh_ & 15) * 128 + hi * 8; \
        _Pragma("unroll") for (int d0 = 0; d0 < 8; ++d0) qn[d0] = *(const bf16x8*)(qp + d0 * 16); } while (0)
    bf16x8 qn[8];
    if (gw < NB * NH * 128) { const int wu_first = SW_UNIT(gw); SW_QLOAD(wu_first); }
    for (int wu0 = gw; wu0 < NB * NH * 128; wu0 += NGW) {
        const int wu = SW_UNIT(wu0);
        const int bh = wu >> 7, rb = wu & 127, b = bh >> 4, hh = bh & 15;
        bf16x8 qr[8];
#pragma unroll
        for (int d0 = 0; d0 < 8; ++d0) qr[d0] = qn[d0];
        const bf16_t* Kg = P.K + (size_t)b * SEQ * P.kpitch + hh * 128;
        const bf16_t* Vg = P.VT + (size_t)b * SEQ * P.kpitch + hh * 128;
        f32x16 o[4];
#pragma unroll
        for (int d = 0; d < 4; ++d)
#pragma unroll
            for (int r = 0; r < 16; ++r) o[d][r] = 0.f;
        float R = 0.f;
        for (int jt = rb; jt >= 0; --jt) {
            {
                bf16x8 ks[8], vs[8];
#pragma unroll
                for (int i = 0; i < 8; ++i) { const int id = lane + 64 * i; ks[i] = *(const bf16x8*)(Kg + (size_t)(jt * 32 + (id >> 4)) * P.kpitch + (id & 15) * 8); }
#pragma unroll
                for (int i = 0; i < 8; ++i) { const int id = lane + 64 * i; vs[i] = *(const bf16x8*)(Vg + (size_t)(jt * 32 + (id >> 4)) * P.kpitch + (id & 15) * 8); }
#pragma unroll
                for (int i = 0; i < 8; ++i) { const int id = lane + 64 * i, row = id >> 4, c = id & 15; *(LAS bf16x8*)(wl + row * 256 + ((c ^ (row & 15)) << 4)) = ks[i]; }
#pragma unroll
                for (int i = 0; i < 8; ++i) { const int id = lane + 64 * i; *(LAS bf16x8*)(wl + VOFF + (id >> 4) * VROW + (id & 15) * 16) = vs[i]; }
            }
            LDS_WAIT();
            f32x16 p;
#pragma unroll
            for (int r = 0; r < 16; ++r) p[r] = 0.f;
#pragma unroll
            for (int d0 = 0; d0 < 8; ++d0) { const bf16x8 kf = *(const LAS bf16x8*)(wl + (kfb ^ (d0 << 5))); p = MFMA32(kf, qr[d0], p); }
            stick_half(p, R, jt == rb, r32, hi, C2);
            const bf16x8 pb0 = pack8(p[0], p[1], p[2], p[3], p[4], p[5], p[6], p[7]), pb1 = pack8(p[8], p[9], p[10], p[11], p[12], p[13], p[14], p[15]);
#pragma unroll
            for (int i = 0; i < 8; ++i) {
                typedef short s16x4_ __attribute__((ext_vector_type(4)));
                const s16x4_ t0 = __builtin_amdgcn_ds_read_tr16_b64_v4i16((LAS s16x4_*)(wl + vfb + (i >> 2) * 16 * VROW + (i & 3) * 64));
                const s16x4_ t1 = __builtin_amdgcn_ds_read_tr16_b64_v4i16((LAS s16x4_*)(wl + vfb + (i >> 2) * 16 * VROW + 8 * VROW + (i & 3) * 64));
                const bf16x8 vf = {t0[0], t0[1], t0[2], t0[3], t1[0], t1[1], t1[2], t1[3]};
                o[i & 3] = MFMA32(vf, (i >> 2) ? pb1 : pb0, o[i & 3]); }
            LDS_WAIT();
            if (__all(R < -46.0f)) break;
        }
        if (wu0 + NGW < NB * NH * 128) { const int wu_next = SW_UNIT(wu0 + NGW); SW_QLOAD(wu_next); }
        {
            constexpr int OSTR = 144;
            bf16_t* og = P.O + ((size_t)b * SEQ + 32 * rb) * P.opitch + hh * 128;
#pragma unroll
            for (int h = 0; h < 2; ++h) {
#pragma unroll
                for (int dd = 0; dd < 2; ++dd)
#pragma unroll
                    for (int g = 0; g < 4; ++g) { const int d = 2 * h + dd;
                        *(LAS u32x2*)(wl + r32 * OSTR + (dd * 32 + 8 * g + 4 * hi) * 2) = (u32x2){pk2(o[d][4 * g], o[d][4 * g + 1]), pk2(o[d][4 * g + 2], o[d][4 * g + 3])}; }
                LDS_WAIT();
#pragma unroll
                for (int i = 0; i < 4; ++i) { const int row = 8 * i + (lane >> 3), ch = lane & 7;
                    const u32x4 v = *(const LAS u32x4*)(wl + row * OSTR + ch * 16);
                    *(u32x4*)(og + (size_t)row * P.opitch + h * 64 + ch * 8) = v; }
                LDS_WAIT();
            }
        }
    }
#undef SW_UNIT
#undef SW_QLOAD
}

template <int MODE>
DI_ void attn_phase(LAS unsigned char* lds, const AttnP& P, int G, int bid) {
    if (__builtin_amdgcn_readfirstlane(threadIdx.x >> 6) >= 4) __builtin_amdgcn_s_setprio(1); else __builtin_amdgcn_s_setprio(0);
    if constexpr (MODE == 0) { const int total = 4 * P.nh * 16;
        for (int L = bid; L < total; L += G) { const int qb = (L >> 3) & 15, bh = (L & 7) + 8 * (L >> 7); attn_unit<MODE>(lds, P, bh / P.nh, bh % P.nh, qb); }
    } else { const int total = 4 * P.nh * 16;
        for (int L2 = 2 * bid; L2 < total; L2 += (L2 & 1) ? 2 * G - 1 : 1) { const int L = L2 >> 1, bh = (L & 7) + 8 * (L >> 6); int x = (L >> 3) & 7;
            if (MODE == 2 && (G & 63) == 0 && (((L - bid) / G) & 1)) x = 7 - x;
            attn_unit<MODE>(lds, P, bh / P.nh, bh % P.nh, (L2 & 1) ? 15 - x : x); }
    }
    __builtin_amdgcn_s_setprio(0);
}
struct Params { const float* in[20]; float* out; unsigned char* ws; int ph_lo, ph_hi; };
#ifndef DBG_MASK
#define DBG_MASK 0xFFFF
#endif
#define EN(k) (((DBG_MASK) >> (k)) & 1)
enum { SUB_N = 0, SUB_G1 = 1, SUB_A = 2, SUB_G3 = 3, SUB_G4 = 4, SUB_GLAT = 5, SUB_N1B = 6, SUB_G2 = 7, SUB_KN = 8, SUB_FINAL = 9 };

typedef const __attribute__((address_space(4))) Params* KParams;
DI_ KParams kparams() { auto kp = __builtin_amdgcn_kernarg_segment_ptr(); asm volatile("" : "+s"(kp)); return (KParams)kp; }
#define WSPTRS() KParams kp_ = kparams(); unsigned char* ws = kp_->ws; float* xout = kp_->out; \
    bf16_t* WB = (bf16_t*)(ws + WS_WB); bf16_t* Hb = (bf16_t*)(ws + WS_H); bf16_t* Qb = (bf16_t*)(ws + WS_Q); bf16_t* Kb = (bf16_t*)(ws + WS_K); bf16_t* VTb = (bf16_t*)(ws + WS_VT); \
    float* CS = (float*)(ws + WS_CS); float* LF = (float*)(ws + WS_LF); float* CUM = (float*)(ws + WS_CUM); \
    float* LAT = (float*)(ws + WS_LAT); bf16_t* QG = (bf16_t*)(ws + WS_QG); bf16_t* KL = (bf16_t*)(ws + WS_KL); bf16_t* KVNT = (bf16_t*)(ws + WS_KVNT); \
    bf16_t* QN = (bf16_t*)(ws + WS_QN); bf16_t* KVN = (bf16_t*)(ws + WS_KVN); \
    float* KNL = (float*)(ws + 65536); \
    const float* xin = (l == 0) ? kp_->in[0] : xout; \
    (void)WB; (void)Hb; (void)Qb; (void)Kb; (void)VTb; (void)CS; (void)LF; (void)CUM; (void)LAT; (void)QG; (void)KL; (void)KVNT; (void)QN; (void)KVN; (void)KNL; (void)xin; (void)xout
#define PIN(i) (kp_->in[i])
__global__ void __launch_bounds__(512) fwd_megakernel(Params p) {
    extern __shared__ __attribute__((aligned(16))) unsigned char lds_raw[];
    LAS unsigned char* lds = (LAS unsigned char*)lds_raw;
    cg::grid_group grid = cg::this_grid();
    const int G = gridDim.x, bid = blockIdx.x, NGW = G * 8;
    const int ph_hi = p.ph_hi;
    if (threadIdx.x < 64) ((LAS unsigned*)(lds + LDS_CTL_OFF))[threadIdx.x] = 0u;
    __syncthreads();
    const XcdBarrier xbar = xcd_barrier_post((unsigned*)p.ws, (volatile LAS unsigned*)(lds + LDS_CTL_OFF));
#ifdef DBG_REPEAT
    bool rep_done = false;
#endif
    for (int ph = p.ph_lo; ph < ph_hi; ++ph) {
        int tid_ = threadIdx.x; asm volatile("" : "+v"(tid_));
        const int tid = tid_, lane = tid & 63, wave = __builtin_amdgcn_readfirstlane(tid >> 6), gw = bid * 8 + wave;
        int l, sub, grp = 0;
        if (ph < 5) { l = 0; sub = ph; }
        else if (ph < 12) { l = 1; const int s = ph - 5; sub = s == 0 ? SUB_N : s == 1 ? SUB_GLAT : s == 2 ? SUB_N1B : s == 3 ? SUB_G2 : s == 4 ? SUB_A : s == 5 ? SUB_G3 : SUB_G4; }
        else if (ph < 17) { l = 2; sub = ph - 12; }
        else if (ph < 22) { l = 3; sub = ph - 17; }
        else { l = 4; sub = SUB_FINAL; }

        if (EN(0) && sub == SUB_N) { WSPTRS();
            LAS float* scr = (LAS float*)(lds + wave * 16384);
            if (l == 1) {
                const float* w_in = PIN(6);
                conv_seg(w_in, 2496, 1024, 0, 2496, WB + WB1_LAT, 0, scr, gw, NGW, lane);
                for (int it = gw; it < 256; it += NGW) {
                    if (it < 128) { const int h = it >> 3, kb = (it >> 1) & 3, nb = it & 1; tr_item(PIN(8), 3072, 256, 64 * kb, h * 192 + 128 + 32 * nb, WB + WB1_Q, h * 192 + 128 + 32 * nb, scr, lane); }
                    else { const int i2 = it - 128, kb = i2 >> 6, hb = i2 & 63, head = hb >> 2, dsub = hb & 3; tr_item(PIN(10), 4096, 128, 64 * kb, head * 256 + 128 + 32 * dsub, WB + WB1_V, head * 128 + 32 * dsub, scr, lane); } }
                conv_seg(PIN(11), 1024, 2048, 0, 1024, WB + WB1_O, 0, scr, gw, NGW, lane);
            } else {
                const float* w_in = l == 0 ? PIN(3) : l == 2 ? PIN(13) : PIN(17); const float* w_out = l == 0 ? PIN(4) : l == 2 ? PIN(15) : PIN(18);
                conv_seg(w_in, l == 2 ? 8208 : 8192, 1024, 0, 8192, WB + WB_IN, 0, scr, gw, NGW, lane);
                conv_seg(w_out, 1024, 2048, 0, 1024, WB + WB_O, 0, scr, gw, NGW, lane);
            }
            const float* gain = l == 0 ? PIN(2) : l == 1 ? PIN(5) : l == 2 ? PIN(12) : PIN(16);
            LAS float* wfl = (LAS float*)lds;
            if (l == 2) { __syncthreads();
                for (int idx = tid; idx < 16384; idx += 512) { const int k = idx >> 4, jj = idx & 15; wfl[jj * 1024 + k] = PIN(13)[(size_t)k * 8208 + 8192 + jj]; }
                __syncthreads(); }
            f32x4 nv[4], gg4[4];
#pragma unroll
            for (int jj = 0; jj < 4; ++jj) { gg4[jj] = *(const f32x4*)(gain + 4 * lane + 256 * jj); nv[jj] = gw < T ? *(const f32x4*)(xin + (size_t)gw * DM + 4 * lane + 256 * jj) : (f32x4){0.f, 0.f, 0.f, 0.f}; }
            for (int m = gw; m < T; m += NGW) {
                f32x4 v[4]; float s = 0.f;
#pragma unroll
                for (int jj = 0; jj < 4; ++jj) { v[jj] = nv[jj]; s += (v[jj].x * v[jj].x + v[jj].y * v[jj].y) + (v[jj].z * v[jj].z + v[jj].w * v[jj].w); }
                if (m + NGW < T) {
#pragma unroll
                    for (int jj = 0; jj < 4; ++jj) nv[jj] = *(const f32x4*)(xin + (size_t)(m + NGW) * DM + 4 * lane + 256 * jj); }
                const float r = 1.0f / sqrtf(wave_sum(s) * (1.0f / DM) + EPS);
#pragma unroll
                for (int jj = 0; jj < 4; ++jj) { const f32x4 gg = gg4[jj]; v[jj] = (v[jj] * r) * gg;
                    *(u32x2*)(Hb + (size_t)m * DM + 4 * lane + 256 * jj) = (u32x2){pk2(v[jj].x, v[jj].y), pk2(v[jj].z, v[jj].w)}; }
                if (l == 2) {
                    float a16[16];
#pragma unroll
                    for (int jh = 0; jh < 16; ++jh) { float a = 0.f;
#pragma unroll
                        for (int jj = 0; jj < 4; ++jj) { const f32x4 w = *(const LAS f32x4*)(wfl + jh * 1024 + 4 * lane + 256 * jj); a += (v[jj].x * w.x + v[jj].y * w.y) + (v[jj].z * w.z + v[jj].w * w.w); }
                        a16[jh] = a; }
                    float a8[8], a4[4], a2[2], a1;
                    { const bool up = (lane & 32) != 0;
#pragma unroll
                      for (int i = 0; i < 8; ++i) { const float keep = up ? a16[8 + i] : a16[i], send = up ? a16[i] : a16[8 + i]; a8[i] = keep + __shfl_xor(send, 32); } }
                    { const bool up = (lane & 16) != 0;
#pragma unroll
                      for (int i = 0; i < 4; ++i) { const float keep = up ? a8[4 + i] : a8[i], send = up ? a8[i] : a8[4 + i]; a4[i] = keep + __shfl_xor(send, 16); } }
                    { const bool up = (lane & 8) != 0;
#pragma unroll
                      for (int i = 0; i < 2; ++i) { const float keep = up ? a4[2 + i] : a4[i], send = up ? a4[i] : a4[2 + i]; a2[i] = keep + __shfl_xor(send, 8); } }
                    { const bool up = (lane & 4) != 0; const float keep = up ? a2[1] : a2[0], send = up ? a2[0] : a2[1]; a1 = keep + __shfl_xor(send, 4); }
                    a1 += __shfl_xor(a1, 2); a1 += __shfl_xor(a1, 1);
                    if ((lane & 3) == 0) { const int jh = ((lane >> 5) & 1) * 8 + ((lane >> 4) & 1) * 4 + ((lane >> 3) & 1) * 2 + ((lane >> 2) & 1);
                        const float f = a1 + PIN(14)[jh]; LF[(size_t)m * 16 + jh] = -(fmaxf(-f, 0.f) + log1pf(expf(-fabsf(f)))); } }
            }
            if (l == 2) __syncthreads();
        } else if (EN(1) && (sub == SUB_G1 || sub == SUB_G2)) { WSPTRS();
            if (l == 2 && bid < 64) {
                const int b = bid >> 4, h = bid & 15; float v[8]; float run = 0.f;
#pragma unroll
                for (int e = 0; e < 8; ++e) { run += LF[((size_t)b * SEQ + 8 * tid + e) * 16 + h]; v[e] = run; }
                float inc = run;
#pragma unroll
                for (int o = 1; o < 64; o <<= 1) { const float t = __shfl_up(inc, o); if (lane >= o) inc += t; }
                LAS float* wt = (LAS float*)lds;
                if (lane == 63) wt[wave] = inc;
                __syncthreads();
                float off = inc - run;
                for (int w = 0; w < wave; ++w) off += wt[w];
                float* cp = CUM + ((size_t)b * NH + h) * SEQ + 8 * tid;
                *(f32x4*)cp = (f32x4){v[0] + off, v[1] + off, v[2] + off, v[3] + off} * (-LOG2E); *(f32x4*)(cp + 4) = (f32x4){v[4] + off, v[5] + off, v[6] + off, v[7] + off} * (-LOG2E);
                __syncthreads();
            }
            const int ng = 2;
            for (int gi = 0; gi < ng; ++gi) {
                pg8::Gemm g; pg8::EpiBf16K E; E.split_cols = 0; E.split_stride = 0; E.knp = nullptr;
                if (sub == SUB_G1) {
                    if (gi == 0) { g = pg8::Gemm{Hb, WB + WB_IN, T, l == 2 ? 4096 : 6144, 1024}; E.O = Qb; E.ldc = 2048; E.split_cols = 2048; E.split_stride = (size_t)(WS_K - WS_Q) / 2; if (l == 2) E.knp = CS; }
                    else { if (l != 2) continue; g = pg8::Gemm{WB + WB_IN + (size_t)4096 * 1024, Hb, 2048, T, 1024}; E.O = VTb; E.ldc = T; }
                } else {
                    if (gi == 0) { g = pg8::Gemm{QN, WB + WB1_Q, T, 3072, 256}; E.O = QG; E.ldc = 3072; }
                    else continue;
                }
                pg8::StaticOrder S; S.init(g.M, g.N, G, bid);
                pg8::gemm_phase<pg8::EpiBf16K, pg8::StaticOrder, true, true>(lds, g, S, E);
            }
        } else if (EN(2) && sub == SUB_GLAT) { WSPTRS();
            { const int jb0 = G > 128 ? bid - 128 : bid, jbs = G > 128 ? G - 128 : G;
              if (jb0 >= 0) {
                {
                const int* pos = (const int*)PIN(1);
                for (int idx = jb0 * 512 + tid; idx < T * 32; idx += jbs * 512) { const int tok = idx >> 5, i = idx & 31;
                    const float invf = powf(10000.0f, -(float)(2 * i) / 64.0f); const float ang = (float)pos[tok] * invf;
                    const double ad = (double)ang, kq = rint(ad * 0.15915494309189535); const float rf = (float)(ad - kq * 6.283185307179586);
                    CS[idx] = cosf(rf); CS[(size_t)T * 32 + idx] = sinf(rf); }
                }
                { LAS float* wkv = (LAS float*)lds; LAS float* wql = wkv + 128 * 132;
                  for (int job = jb0; job < 128; job += jbs) { const int h = job >> 3, kg = job & 7;
                      for (int idx = tid; idx < 128 * 32; idx += 512) { const int c = idx >> 5, d4 = idx & 31; *(LAS f32x4*)(wkv + c * 132 + 4 * d4) = *(const f32x4*)(PIN(10) + (size_t)c * 4096 + h * 256 + 4 * d4); }
                      for (int idx = tid; idx < 32 * 32; idx += 512) { const int kl = idx >> 5, d4 = idx & 31; *(LAS f32x4*)(wql + kl * 132 + 4 * d4) = *(const f32x4*)(PIN(8) + (size_t)(kg * 32 + kl) * 3072 + h * 192 + 4 * d4); }
                      __syncthreads();
                      const int kl = tid >> 4, cg = tid & 15; float acc[8];
#pragma unroll
                      for (int i = 0; i < 8; ++i) acc[i] = 0.f;
#pragma unroll 4
                      for (int d4 = 0; d4 < 32; ++d4) { const f32x4 q = *(const LAS f32x4*)(wql + kl * 132 + 4 * d4);
#pragma unroll
                          for (int i = 0; i < 8; ++i) { const f32x4 w = *(const LAS f32x4*)(wkv + (cg + 16 * i) * 132 + 4 * d4); acc[i] += (q.x * w.x + q.y * w.y) + (q.z * w.z + q.w * w.w); } }
#pragma unroll
                      for (int i = 0; i < 8; ++i) WB[WB1_Q + (size_t)(h * 192 + cg + 16 * i) * 256 + kg * 32 + kl] = (bf16_t)(pk2(acc[i], 0.f) & 0xffffu);
                      __syncthreads(); } }
              } }
            pg8::Gemm g{Hb, WB + WB1_LAT, T, 512, 1024}; pg8::EpiF32<false> E{nullptr, LAT, 512};
            pg8::StaticOrder S; S.init(g.M, g.N, G, bid);
            pg8::gemm_phase<pg8::EpiF32<false>, pg8::StaticOrder, true, true>(lds, g, S, E);
        } else if (EN(9) && sub == SUB_G4) { WSPTRS();
            bf16_t* A = Qb;
            pg8::Gemm g{A, WB + (l == 1 ? WB1_O : WB_O), T, 1024, 2048}; pg8::EpiF32<true> E{xin, xout, 1024};
            pg8::StaticOrder S; S.init(g.M, g.N, G, bid);
            pg8::gemm_phase<pg8::EpiF32<true>, pg8::StaticOrder, true, true>(lds, g, S, E);
        } else if (EN(3) && sub == SUB_G3) { WSPTRS();
            pg8::Gemm g{Hb, WB + (l == 1 ? WB1_G : WB_IN + (size_t)6144 * 1024), T, 2048, 1024}; pg8::EpiGate E{Qb, 2048};
            pg8::StaticOrder S; S.init(g.M, g.N, G, bid);
            pg8::gemm_phase<pg8::EpiGate, pg8::StaticOrder, true, true>(lds, g, S, E);
        } else if (EN(4) && sub == SUB_N1B) { WSPTRS();
            const f32x4 gq = *(const f32x4*)(PIN(7) + 4 * lane), gk = *(const f32x4*)(PIN(9) + 4 * (lane & 31));
            f32x4 na = (f32x4){0.f, 0.f, 0.f, 0.f}, nb = na;
            if (gw < T) { na = *(const f32x4*)(LAT + (size_t)gw * 512 + 4 * lane); nb = *(const f32x4*)(LAT + (size_t)gw * 512 + 256 + 4 * lane); }
            for (int m = gw; m < T; m += NGW) {
                const f32x4 a = na, bq = nb;
                if (m + NGW < T) { na = *(const f32x4*)(LAT + (size_t)(m + NGW) * 512 + 4 * lane); nb = *(const f32x4*)(LAT + (size_t)(m + NGW) * 512 + 256 + 4 * lane); }
                const float rq = 1.0f / sqrtf(wave_sum((a.x * a.x + a.y * a.y) + (a.z * a.z + a.w * a.w)) * (1.0f / 256.0f) + EPS);
                const f32x4 yq = (a * rq) * gq;
                *(u32x2*)(QN + (size_t)m * 256 + 4 * lane) = (u32x2){pk2(yq.x, yq.y), pk2(yq.z, yq.w)};
                const float sk = lane < 32 ? (bq.x * bq.x + bq.y * bq.y) + (bq.z * bq.z + bq.w * bq.w) : 0.f;
                const float rk = 1.0f / sqrtf(wave_sum(sk) * (1.0f / 128.0f) + EPS);
                float kk2 = 0.f;
                if (lane < 32) { const f32x4 yk = (bq * rk) * gk; kk2 = (yk.x * yk.x + yk.y * yk.y) + (yk.z * yk.z + yk.w * yk.w);
                    *(u32x2*)(KL + (size_t)m * 192 + 4 * lane) = (u32x2){pk2(yk.x, yk.y), pk2(yk.z, yk.w)}; }
                f32x4 pr; pr.x = __shfl_xor(bq.x, 8); pr.y = __shfl_xor(bq.y, 8); pr.z = __shfl_xor(bq.z, 8); pr.w = __shfl_xor(bq.w, 8);
                if (lane >= 32 && lane < 48) { const int i0 = 4 * (lane & 7); const bool second = lane >= 40;
                    const f32x4 c = *(const f32x4*)(CS + (size_t)m * 32 + i0), s = *(const f32x4*)(CS + (size_t)T * 32 + (size_t)m * 32 + i0);
                    const f32x4 x1 = second ? pr : bq, x2 = second ? bq : pr;
                    const f32x4 y = second ? (x1 * s + x2 * c) : (x1 * c - x2 * s);
                    *(u32x2*)(KL + (size_t)m * 192 + 128 + 4 * (lane - 32)) = (u32x2){pk2(y.x, y.y), pk2(y.z, y.w)}; kk2 = (y.x * y.x + y.y * y.y) + (y.z * y.z + y.w * y.w); }
                kk2 = wave_sum(kk2); if (lane == 0) KNL[m] = kk2;
            }
        } else if (sub == SUB_A) { WSPTRS();
            AttnP P; P.cum = CUM; P.cs = CS; P.KR = nullptr; P.kn2 = CS;
            P.khead = 128; P.vheadrows = 128; P.krpitch = 64; P.WV = WB + WB1_V;
            if (EN(6) && l == 1) { P.Q = QG; P.K = KL; P.KR = KL + 128; P.VT = KVNT; P.O = Qb; P.qpitch = 3072; P.kpitch = 192; P.krpitch = 192; P.khead = 0; P.vheadrows = 0; P.opitch = 2048; P.nh = 16; P.kn2 = KNL;
#if defined(DBG_REPEAT) && defined(DBG_VAR)
                attn_phase<1>(lds, P, G, bid, (ph == DBG_REPEAT && !rep_done) ? DBG_VAR : 0); }
#else
                attn_phase<1>(lds, P, G, bid); }
#endif
            else { P.Q = Qb; P.K = Kb; P.VT = VTb; P.O = Qb; P.qpitch = 2048; P.kpitch = 2048; P.opitch = 2048; P.nh = 16;
                if (EN(7) && l == 2) attn_phase<2>(lds, P, G, bid); else if (EN(5)) {
                    stick_wave_phase(lds, P, gw, NGW);
                } }
        } else if (EN(8)) { WSPTRS();
            f32x4 nv[4], gg4[4];
#pragma unroll
            for (int jj = 0; jj < 4; ++jj) { gg4[jj] = *(const f32x4*)(PIN(19) + 4 * lane + 256 * jj); nv[jj] = gw < T ? *(const f32x4*)(xout + (size_t)gw * DM + 4 * lane + 256 * jj) : (f32x4){0.f, 0.f, 0.f, 0.f}; }
            for (int m = gw; m < T; m += NGW) {
                float* xr = xout + (size_t)m * DM + 4 * lane; f32x4 v[4]; float s = 0.f;
#pragma unroll
                for (int jj = 0; jj < 4; ++jj) { v[jj] = nv[jj]; s += (v[jj].x * v[jj].x + v[jj].y * v[jj].y) + (v[jj].z * v[jj].z + v[jj].w * v[jj].w); }
                if (m + NGW < T) {
#pragma unroll
                    for (int jj = 0; jj < 4; ++jj) nv[jj] = *(const f32x4*)(xout + (size_t)(m + NGW) * DM + 4 * lane + 256 * jj); }
                const float r = 1.0f / sqrtf(wave_sum(s) * (1.0f / DM) + EPS);
#pragma unroll
                for (int jj = 0; jj < 4; ++jj) *(f32x4*)(xr + 256 * jj) = (v[jj] * r) * gg4[jj];
            }
        }
        if (ph + 1 < ph_hi) { if (p.ph_lo < 0) grid.sync(); else xcd_barrier(xbar); }
#ifdef DBG_REPEAT
        if (ph == DBG_REPEAT && !rep_done) { rep_done = true; --ph; }
#endif
    }
}

extern "C" void kernel_launch(void* const* d_in, const int* in_sizes, int n_in, void* d_out, int out_size, void* d_ws, size_t ws_size, hipStream_t stream) {
    static int grid = 0;
    if (grid == 0) {
        if (n_in != 20 || in_sizes[0] != T * DM || out_size != T * DM || ws_size < WS_END) { fprintf(stderr, "kernel_launch: unexpected shapes (n_in %d, in0 %d, out %d, ws %zu)\n", n_in, n_in > 0 ? in_sizes[0] : -1, out_size, ws_size); grid = -1; return; }
        int dev = 0, cus = 0, per_cu = 0;
        (void)hipGetDevice(&dev); (void)hipDeviceGetAttribute(&cus, hipDeviceAttributeMultiprocessorCount, dev);
        if (hipFuncSetAttribute((const void*)fwd_megakernel, hipFuncAttributeMaxDynamicSharedMemorySize, LDS_BYTES) != hipSuccess) { fprintf(stderr, "kernel_launch: hipFuncSetAttribute failed\n"); grid = -1; return; }
        if (hipOccupancyMaxActiveBlocksPerMultiprocessor(&per_cu, (const void*)fwd_megakernel, 512, LDS_BYTES) != hipSuccess || per_cu < 1) { fprintf(stderr, "kernel_launch: occupancy query says %d\n", per_cu); per_cu = 1; }
        (void)hipGetLastError();
        if (cus <= 0) cus = 256;
        grid = cus;
    }
    if (grid < 0) return;
    if (hipMemsetAsync(d_ws, 0, 16384, stream) != hipSuccess) { fprintf(stderr, "kernel_launch: memset failed\n"); return; }
    Params p{};
    for (int i = 0; i < 20; ++i) p.in[i] = (const float*)d_in[i];
    p.out = (float*)d_out; p.ws = (unsigned char*)d_ws;
#if MK_ONE_LAUNCH
    p.ph_lo = 0; p.ph_hi = NPH;
    void* args[] = {&p};
    hipError_t e = hipLaunchCooperativeKernel((const void*)fwd_megakernel, dim3(grid), dim3(512), args, LDS_BYTES, stream);
    if (e != hipSuccess) fprintf(stderr, "kernel_launch: cooperative launch failed: %s (grid %d)\n", hipGetErrorString(e), grid);
#else
    for (int ph = 0; ph < NPH; ++ph) { p.ph_lo = ph; p.ph_hi = ph + 1; hipLaunchKernelGGL(fwd_megakernel, dim3(grid), dim3(512), LDS_BYTES, stream, p); }
#endif
}
```

```cpp
#include <hip/hip_runtime.h>
#include <hip/hip_cooperative_groups.h>
#include <cstdio>
#include <cstdint>
#include <cmath>
namespace cg = cooperative_groups;
#ifndef MK_ONE_LAUNCH
#define MK_ONE_LAUNCH 1
#endif
namespace pg8 {
#define PG8_LAS __attribute__((address_space(3)))
typedef unsigned short bf16_t;
typedef short bf16x8 __attribute__((ext_vector_type(8)));
typedef float f32x4 __attribute__((ext_vector_type(4)));
typedef unsigned u32x4 __attribute__((ext_vector_type(4)));
constexpr int BM = 256, BK = 64, HALF = 128, HTB = HALF * BK * 2  , STAGE_BYTES = 8 * HTB, NXCD = 8, WGM = 8;

__host__ __device__ __forceinline__ int lds_byte(int r, int c) { const int st = (r >> 4) * 2 + (c >> 5), rr = r & 15, cc = c & 31, ob = rr * 64 + cc * 2; return st * 1024 + (ob ^ (((ob >> 9) & 1) << 5)); }
__host__ __device__ __forceinline__ void stage_rc(int b, int& R, int& C) { const int st = b / 1024, sb = b % 1024, swz = sb ^ (((sb >> 9) & 1) << 5); R = (st >> 1) * 16 + swz / 64; C = (st & 1) * 32 + (swz % 64) / 2; }
__host__ __device__ __forceinline__ int perm32(int rho) { const int n = rho >> 4, i = rho & 15; return 8 * (i >> 2) + 4 * n + (i & 3); }

struct Unit { int pm, pn; };
struct Gemm { const bf16_t* A; const bf16_t* Bt; int M, N, K; };

struct StaticOrder {
    int nM, nN, nwg, G, c;
    __host__ __device__ void init(int M, int N, int G_, int c_) { nM = M / BM; nN = N / BM; nwg = nM * nN; G = G_; c = c_; }
    __host__ __device__ bool next(int i, Unit& u) const {
        const long L = (long)i * G + c; if (L >= nwg) return false;
        int wgid = (int)L; { const int q = nwg / NXCD, r = nwg % NXCD, xcd = wgid % NXCD, off = wgid / NXCD; wgid = (xcd < r ? xcd * (q + 1) : r * (q + 1) + (xcd - r) * q) + off; }
        const int nig = WGM * nN, gid = wgid / nig, fm = gid * WGM, gsz = (nM - fm) < WGM ? (nM - fm) : WGM;
        u.pm = fm + ((wgid % nig) % gsz); u.pn = (wgid % nig) / gsz; return true;
    }
    __device__ __forceinline__ void a_ready(const Unit&) const {}
    __device__ __forceinline__ void done(const Unit&) const {}
};

__device__ __forceinline__ unsigned cvt_pk_bf16(float lo, float hi) { unsigned r; asm volatile("v_cvt_pk_bf16_f32 %0, %1, %2" : "=v"(r) : "v"(lo), "v"(hi)); return r; }
typedef float f32x2 __attribute__((ext_vector_type(2)));
__device__ __forceinline__ f32x2 gelu_pk(f32x2 v) {
    const f32x2 av = __builtin_elementwise_abs(v), d = av * 0.2316418882f + 1.0f;
    f32x2 t; t.x = __builtin_amdgcn_rcpf(d.x); t.y = __builtin_amdgcn_rcpf(d.y);
    f32x2 q = t * 0.5307027145f + (-0.7265760135f); q = q * t + 0.7107068705f; q = q * t + (-0.142248368f); q = q * t + 0.127414796f; q = q * t;
    const f32x2 s = (v * v) * (-0.72134752044f);
    f32x2 e; e.x = __builtin_amdgcn_exp2f(s.x); e.y = __builtin_amdgcn_exp2f(s.y);
    const f32x2 m = v * (q * e), r = v - m;
    f32x2 o; o.x = v.x < 0.f ? m.x : r.x; o.y = v.y < 0.f ? m.y : r.y; return o;
}

template <int ACT  > struct EpiBf16 {
    static constexpr bool PERM = true, AFTER_DRAIN = false; static_assert(ACT == 0 || ACT == 1, "EpiBf16: ACT is 0 (none) or 1 (gelu_pk)");
    bf16_t* O; int ldc; const float* bias; int split_cols; size_t split_stride; float scale0;
    __device__ __forceinline__ void operator()(const f32x4 (&acc)[2][2][4][2], const Unit& u, int wr, int wc, int fr, int fq) const {
        const int row0 = u.pm * BM + wr * 64 + fr; int colt = u.pn * BM; bf16_t* base = O;
        float sc = 1.f; if (split_cols) { const int t = colt / split_cols; base += (size_t)t * split_stride; colt -= t * split_cols; if (t == 0) sc = scale0; }
        const int col0 = colt + wc * 32 + 8 * fq, bcol0 = u.pn * BM + wc * 32 + 8 * fq;
        f32x4 bv[2][2];
#pragma unroll
        for (int bj = 0; bj < 2; ++bj)
#pragma unroll
            for (int n = 0; n < 2; ++n) bv[bj][n] = bias ? *(const f32x4*)(bias + bcol0 + bj * HALF + 4 * n) : (f32x4){0.f, 0.f, 0.f, 0.f};
#pragma unroll
        for (int ai = 0; ai < 2; ++ai)
#pragma unroll
            for (int m = 0; m < 4; ++m) { bf16_t* rowp = base + (size_t)(row0 + ai * HALF + m * 16) * ldc + col0;
#pragma unroll
                for (int bj = 0; bj < 2; ++bj) { f32x4 v0 = acc[ai][bj][m][0] + bv[bj][0], v1 = acc[ai][bj][m][1] + bv[bj][1];
                    if (ACT == 1) { f32x2 a = gelu_pk((f32x2){v0[0], v0[1]}), b = gelu_pk((f32x2){v0[2], v0[3]}), c = gelu_pk((f32x2){v1[0], v1[1]}), d = gelu_pk((f32x2){v1[2], v1[3]});
                        v0 = (f32x4){a.x, a.y, b.x, b.y}; v1 = (f32x4){c.x, c.y, d.x, d.y}; }
                    v0 = v0 * sc; v1 = v1 * sc; u32x4 w; w.x = cvt_pk_bf16(v0[0], v0[1]); w.y = cvt_pk_bf16(v0[2], v0[3]); w.z = cvt_pk_bf16(v1[0], v1[1]); w.w = cvt_pk_bf16(v1[2], v1[3]);
                    *(u32x4*)(rowp + bj * HALF) = w; } }
    }
};

struct PanelStats {
    unsigned* xbuf;
    unsigned* cnt;
    unsigned* tmo;
    int ntn; float eps;
    unsigned code;
    __device__ __forceinline__ bool run(const f32x4 (&v)[2][2][4][2], const Unit& u, int wr, int wc, int fr, int fq, PG8_LAS unsigned char* lds, int wid, int lane) const {
        typedef float f32x2v __attribute__((ext_vector_type(2)));
        PG8_LAS f32x2v* P = (PG8_LAS f32x2v*)lds;
        PG8_LAS f32x2v* S = (PG8_LAS f32x2v*)(lds + 8192);
        PG8_LAS unsigned* flag = (PG8_LAS unsigned*)(lds + 8192 + 2048);
#pragma unroll
        for (int ai = 0; ai < 2; ++ai)
#pragma unroll
            for (int m = 0; m < 4; ++m) {
                float s = 0.f;
#pragma unroll
                for (int bj = 0; bj < 2; ++bj)
#pragma unroll
                    for (int n = 0; n < 2; ++n) { const f32x4 x = v[ai][bj][m][n]; s += (x[0] + x[1]) + (x[2] + x[3]); }
                s += __shfl_xor(s, 16); s += __shfl_xor(s, 32);
                const float mw = s * (1.0f / 64.0f); float q = 0.f;
#pragma unroll
                for (int bj = 0; bj < 2; ++bj)
#pragma unroll
                    for (int n = 0; n < 2; ++n) { const f32x4 d = v[ai][bj][m][n] - mw; q += (d[0] * d[0] + d[1] * d[1]) + (d[2] * d[2] + d[3] * d[3]); }
                q += __shfl_xor(q, 16); q += __shfl_xor(q, 32);
                if (fq == 0) P[(ai * HALF + wr * 64 + m * 16 + fr) * 4 + wc] = (f32x2v){mw, q};
            }
        asm volatile("s_waitcnt lgkmcnt(0)" ::: "memory"); __builtin_amdgcn_s_barrier(); asm volatile("" ::: "memory");
#if defined(BROKEN_EXCHANGE_NO_WAIT)
#warning BROKEN CONTROL BUILD: the row-statistics exchange does not wait; results are wrong by design
        if (blockIdx.x >= 64) { const long long t0_ = clock64(); while (clock64() - t0_ < 60000) __builtin_amdgcn_s_sleep(8); }
#endif
        const int row = wid * 32 + (lane & 31);
        if (lane < 32) {
            const f32x2v a = P[row * 4 + 0], b = P[row * 4 + 1], c = P[row * 4 + 2], d = P[row * 4 + 3];
            const float mt = (a.x + b.x + c.x + d.x) * 0.25f;
            const float da = a.x - mt, db = b.x - mt, dc = c.x - mt, dd = d.x - mt;
            const float m2 = (a.y + b.y) + (c.y + d.y) + 64.0f * ((da * da + db * db) + (dc * dc + dd * dd));
            unsigned long long* slot = (unsigned long long*)xbuf + ((size_t)(u.pm * BM + row) * 4 + u.pn);
            __hip_atomic_store(slot, ((unsigned long long)__float_as_uint(m2) << 32) | __float_as_uint(mt), __ATOMIC_RELAXED, __HIP_MEMORY_SCOPE_AGENT);
        }
        asm volatile("s_waitcnt vmcnt(0)" ::: "memory");
        if (lane == 0) __hip_atomic_fetch_add(cnt + 64 * u.pm, 1u, __ATOMIC_RELAXED, __HIP_MEMORY_SCOPE_AGENT);
        if (wid == 0) {
            bool dead = false; const unsigned long long t0 = __builtin_amdgcn_s_memrealtime(); const unsigned want = 8u * (unsigned)ntn;
            for (;;) {
#if defined(BROKEN_EXCHANGE_NO_WAIT)
                break;
#endif
                if ((unsigned)__builtin_amdgcn_readfirstlane(__hip_atomic_load(cnt + 64 * u.pm, __ATOMIC_RELAXED, __HIP_MEMORY_SCOPE_AGENT)) >= want) break;
                if (__builtin_amdgcn_s_memrealtime() - t0 > 2000000ull) {
                    if (lane == 0) { unsigned expect = 0u; __hip_atomic_compare_exchange_strong(tmo + 1, &expect, code | (unsigned)(u.pm & 0xff), __ATOMIC_RELAXED, __ATOMIC_RELAXED, __HIP_MEMORY_SCOPE_AGENT);
                                     __hip_atomic_store(tmo, 1u, __ATOMIC_RELAXED, __HIP_MEMORY_SCOPE_AGENT); }
                    dead = true; break; }
                __builtin_amdgcn_s_sleep(2);
            }
            __builtin_amdgcn_fence(__ATOMIC_ACQUIRE, "agent");
            if (lane == 0) flag[0] = dead ? 1u : 0u;
        }
        asm volatile("s_waitcnt vmcnt(0) lgkmcnt(0)" ::: "memory"); __builtin_amdgcn_s_barrier(); asm volatile("" ::: "memory");
        const bool bad = flag[0] != 0u;
        if (lane < 32) {
            const unsigned long long* slot = (const unsigned long long*)xbuf + (size_t)(u.pm * BM + row) * 4; float mt[4], m2[4]; float ms = 0.f;
#pragma unroll
            for (int t = 0; t < 4; ++t) { if (t < ntn) { const unsigned long long w = __hip_atomic_load(slot + t, __ATOMIC_RELAXED, __HIP_MEMORY_SCOPE_AGENT); mt[t] = __uint_as_float((unsigned)w); m2[t] = __uint_as_float((unsigned)(w >> 32)); } else { mt[t] = 0.f; m2[t] = 0.f; } ms += mt[t]; }
            const float mean = ms / (float)ntn; float q = 0.f;
#pragma unroll
            for (int t = 0; t < 4; ++t) if (t < ntn) { const float dm = mt[t] - mean; q += m2[t] + 256.0f * dm * dm; }
            S[row] = (f32x2v){mean, 1.0f / sqrtf(q / (256.0f * (float)ntn) + eps)};
        }
        asm volatile("s_waitcnt lgkmcnt(0)" ::: "memory"); __builtin_amdgcn_s_barrier(); asm volatile("" ::: "memory");
        return bad;
    }
};
struct EpiLnRes {
    static constexpr bool PERM = false, AFTER_DRAIN = true;
    const float* base; float* out; int ldc; const float* bias; PanelStats st; unsigned poison;
    __device__ __forceinline__ void fused(f32x4 (&acc)[2][2][4][2], const Unit& u, int wr, int wc, int fr, int fq, PG8_LAS unsigned char* lds, int wid, int lane) const {
        typedef float f32x2v __attribute__((ext_vector_type(2)));
        const PG8_LAS f32x2v* S = (const PG8_LAS f32x2v*)(lds + 8192);
        const int col0 = u.pn * BM + wc * 32 + 4 * fq;
#pragma unroll
        for (int bj = 0; bj < 2; ++bj)
#pragma unroll
            for (int n = 0; n < 2; ++n) { const f32x4 bv = bias ? *(const f32x4*)(bias + col0 + bj * HALF + n * 16) : (f32x4){0.f, 0.f, 0.f, 0.f};
#pragma unroll
                for (int ai = 0; ai < 2; ++ai)
#pragma unroll
                    for (int m = 0; m < 4; ++m) acc[ai][bj][m][n] += bv; }
        f32x4 pre[4][2][2];
#pragma unroll
        for (int m = 0; m < 4; ++m) { const size_t off = (size_t)(u.pm * BM + wr * 64 + m * 16 + fr) * ldc + col0;
#pragma unroll
            for (int bj = 0; bj < 2; ++bj)
#pragma unroll
                for (int n = 0; n < 2; ++n) pre[m][bj][n] = *(const f32x4*)(base + off + bj * HALF + n * 16); }
        const bool bad = st.run(acc, u, wr, wc, fr, fq, lds, wid, lane) || poison != 0u;
        const float qnan = __builtin_nanf("");
#pragma unroll
        for (int ai = 0; ai < 2; ++ai)
#pragma unroll
            for (int m = 0; m < 4; ++m) { const int r = ai * HALF + wr * 64 + m * 16 + fr; const f32x2v sr = S[r]; const size_t off = (size_t)(u.pm * BM + r) * ldc + col0;
#pragma unroll
                for (int bj = 0; bj < 2; ++bj)
#pragma unroll
                    for (int n = 0; n < 2; ++n) { const f32x4 bs = ai == 0 ? pre[m][bj][n] : *(const f32x4*)(base + off + bj * HALF + n * 16); f32x4 o = bs + (acc[ai][bj][m][n] - sr.x) * sr.y;
                        if (bad) o = (f32x4){qnan, qnan, qnan, qnan}; *(f32x4*)(out + off + bj * HALF + n * 16) = o; }
                if (m & 1) asm volatile("" ::: "memory"); }
    }
};
struct EpiLnResLn {
    static constexpr bool PERM = false, AFTER_DRAIN = true;
    const float* base; float* out; bf16_t* xn; int ldc; const float* bias; PanelStats st1, st2; unsigned poison;
    __device__ __forceinline__ void fused(f32x4 (&acc)[2][2][4][2], const Unit& u, int wr, int wc, int fr, int fq, PG8_LAS unsigned char* lds, int wid, int lane) const {
        typedef float f32x2v __attribute__((ext_vector_type(2))); typedef unsigned u32x2v __attribute__((ext_vector_type(2)));
        const PG8_LAS f32x2v* S = (const PG8_LAS f32x2v*)(lds + 8192);
        const int col0 = u.pn * BM + wc * 32 + 4 * fq;
#pragma unroll
        for (int bj = 0; bj < 2; ++bj)
#pragma unroll
            for (int n = 0; n < 2; ++n) { const f32x4 bv = bias ? *(const f32x4*)(bias + col0 + bj * HALF + n * 16) : (f32x4){0.f, 0.f, 0.f, 0.f};
#pragma unroll
                for (int ai = 0; ai < 2; ++ai)
#pragma unroll
                    for (int m = 0; m < 4; ++m) acc[ai][bj][m][n] += bv; }
        bool bad = st1.run(acc, u, wr, wc, fr, fq, lds, wid, lane) || poison != 0u;
        const float qnan = __builtin_nanf("");
#pragma unroll
        for (int ai = 0; ai < 2; ++ai)
#pragma unroll
            for (int m = 0; m < 4; ++m) { const int r = ai * HALF + wr * 64 + m * 16 + fr; const f32x2v sr = S[r]; const size_t off = (size_t)(u.pm * BM + r) * ldc + col0;
#pragma unroll
                for (int bj = 0; bj < 2; ++bj)
#pragma unroll
                    for (int n = 0; n < 2; ++n) { const f32x4 bs = *(const f32x4*)(base + off + bj * HALF + n * 16); acc[ai][bj][m][n] = bs + (acc[ai][bj][m][n] - sr.x) * sr.y; }
                asm volatile("" : "+v"(acc[ai][0][m][0]), "+v"(acc[ai][0][m][1]), "+v"(acc[ai][1][m][0]), "+v"(acc[ai][1][m][1]));
                if (m & 1) asm volatile("" ::: "memory"); }
        const bool bad1 = bad;
        bad = st2.run(acc, u, wr, wc, fr, fq, lds, wid, lane) || bad;
#pragma unroll
        for (int ai = 0; ai < 2; ++ai)
#pragma unroll
            for (int m = 0; m < 4; ++m) { const int r = ai * HALF + wr * 64 + m * 16 + fr; const f32x2v sr = S[r]; const size_t off = (size_t)(u.pm * BM + r) * ldc + col0;
#pragma unroll
                for (int bj = 0; bj < 2; ++bj)
#pragma unroll
                    for (int n = 0; n < 2; ++n) { const f32x4 x1 = acc[ai][bj][m][n]; *(f32x4*)(out + off + bj * HALF + n * 16) = bad1 ? (f32x4){qnan, qnan, qnan, qnan} : x1;
                        const f32x4 o = (x1 - sr.x) * sr.y; u32x2v w; w.x = cvt_pk_bf16(o[0], o[1]); w.y = cvt_pk_bf16(o[2], o[3]);
                        if (bad) { w.x = 0x7fc07fc0u; w.y = 0x7fc07fc0u; } *(u32x2v*)(xn + off + bj * HALF + n * 16) = w; }
                asm volatile("" ::: "memory"); }
    }
};

template <class Epi, class Sched, bool ALIGN_EPI = false, bool SP2 = false>
__device__ __forceinline__ void gemm_phase(PG8_LAS unsigned char* lds, const Gemm g, const Sched& S, const Epi& E) {
    int tid_ = threadIdx.x; asm volatile("" : "+v"(tid_));
    const int tid = tid_, wid = __builtin_amdgcn_readfirstlane(tid >> 6), lane = tid & 63, wr = wid >> 2, wc = wid & 3, fr = lane & 15, fq = lane >> 4;
    const int K = g.K, nt = K / BK;
    unsigned voffA[2], voffB[2];
#pragma unroll
    for (int i = 0; i < 2; ++i) { int R, C; stage_rc(tid * 16 + i * 8192, R, C); const int Rb = Epi::PERM ? ((R & ~31) + perm32(R & 31)) : R;
        voffA[i] = (unsigned)(R * K + C) * 2u; voffB[i] = (unsigned)(Rb * K + C) * 2u; }
    const size_t kstep = (size_t)(BK * 2);
    const size_t hstep = (size_t)HALF * K * 2;
    const size_t tstep = 2 * hstep;
    const unsigned ldsw = (unsigned)wid * 1024u;
    const int aoff = lds_byte(wr * 64 + fr, fq * 8), boff = lds_byte(wc * 32 + fr, fq * 8);
#define PG8_SA(b, h) (((b) * 2 + (h)) * HTB)
#define PG8_SB(b, h) ((4 + (b) * 2 + (h)) * HTB)
#define PG8_STAGE(bufoff, gbase, voff) do { _Pragma("unroll") for (int _i = 0; _i < 2; ++_i) \
        __builtin_amdgcn_global_load_lds((const unsigned*)((const char*)(gbase) + (voff)[_i]), (PG8_LAS unsigned*)(lds + (bufoff) + ldsw + _i * 8192), 16, 0, 0); } while (0)
#define PG8_LDA(dst, b, h) do { _Pragma("unroll") for (int m = 0; m < 4; ++m) _Pragma("unroll") for (int k = 0; k < 2; ++k) dst[m][k] = *(const PG8_LAS bf16x8*)(lds + PG8_SA(b, h) + aoff + m * 2048 + k * 1024); } while (0)
#define PG8_LDB(dst, b, h) do { _Pragma("unroll") for (int n = 0; n < 2; ++n) _Pragma("unroll") for (int k = 0; k < 2; ++k) dst[n][k] = *(const PG8_LAS bf16x8*)(lds + PG8_SB(b, h) + boff + n * 2048 + k * 1024); } while (0)
#define PG8_MMA(ai, bj, At, Bt) do { __builtin_amdgcn_s_setprio(1); _Pragma("unroll") for (int m = 0; m < 4; ++m) _Pragma("unroll") for (int n = 0; n < 2; ++n) _Pragma("unroll") for (int k = 0; k < 2; ++k) \
        acc[ai][bj][m][n] = __builtin_amdgcn_mfma_f32_16x16x32_bf16(Bt[n][k], At[m][k], acc[ai][bj][m][n], 0, 0, 0); __builtin_amdgcn_s_setprio(0); } while (0)
#define PG8_WAIT_V(n) asm volatile("s_waitcnt vmcnt(" #n ")" ::: "memory")
#define PG8_WAIT_L(n) asm volatile("s_waitcnt lgkmcnt(" #n ")" ::: "memory")
#define PG8_BAR __builtin_amdgcn_s_barrier()
#define PG8_SCHED __builtin_amdgcn_sched_barrier(0)
    Unit cur, nxt; int ui = 0;
    if (!S.next(0, cur)) return;
    f32x4 acc[2][2][4][2];
#pragma unroll
    for (int a = 0; a < 2; ++a)
#pragma unroll
        for (int b = 0; b < 2; ++b)
#pragma unroll
            for (int m = 0; m < 4; ++m)
#pragma unroll
                for (int n = 0; n < 2; ++n) acc[a][b][m][n] = (f32x4){0.f, 0.f, 0.f, 0.f};
    bf16x8 At[4][2], B0[2][2], B1[2][2];
    const char* cA = (const char*)g.A + (size_t)cur.pm * tstep; const char* cB = (const char*)g.Bt + (size_t)cur.pn * tstep;
    S.a_ready(cur);
    if constexpr (SP2) {
        PG8_STAGE(PG8_SB(0, 0), cB, voffB); PG8_STAGE(PG8_SB(0, 1), cB + hstep, voffB); PG8_STAGE(PG8_SA(0, 0), cA, voffA); PG8_STAGE(PG8_SA(0, 1), cA + hstep, voffA);
        if (wr == 1) PG8_BAR;
        PG8_WAIT_V(2); PG8_BAR;
        PG8_STAGE(PG8_SB(1, 0), cB + kstep, voffB); PG8_STAGE(PG8_SA(1, 0), cA + kstep, voffA); PG8_STAGE(PG8_SB(1, 1), cB + hstep + kstep, voffB);
        PG8_WAIT_V(6); PG8_BAR;
    } else {
        PG8_STAGE(PG8_SB(0, 0), cB, voffB); PG8_STAGE(PG8_SA(0, 0), cA, voffA); PG8_STAGE(PG8_SB(0, 1), cB + hstep, voffB); PG8_STAGE(PG8_SA(0, 1), cA + hstep, voffA);
        if (wr == 1) PG8_BAR;
        PG8_WAIT_V(4); PG8_BAR;
        PG8_STAGE(PG8_SB(1, 0), cB + kstep, voffB); PG8_STAGE(PG8_SA(1, 0), cA + kstep, voffA); PG8_STAGE(PG8_SB(1, 1), cB + hstep + kstep, voffB);
        PG8_WAIT_V(6); PG8_BAR;
    }
    for (;;) {
        const bool has_next = S.next(ui + 1, nxt);
        const char* nA = has_next ? (const char*)g.A + (size_t)nxt.pm * tstep : cA; const char* nB = has_next ? (const char*)g.Bt + (size_t)nxt.pn * tstep : cB;
        for (int t = 0; t < nt; t += 2) {
            const bool last = (t == nt - 2);
            const char* a1 = cA + (size_t)(t + 1) * kstep;
            const char* a2 = last ? nA : cA + (size_t)(t + 2) * kstep; const char* b2 = last ? nB : cB + (size_t)(t + 2) * kstep;
            const char* a3 = a2 + kstep; const char* b3 = b2 + kstep;
            if (last && has_next) S.a_ready(nxt);
            if constexpr (SP2) {
            PG8_LDB(B0, 0, 0); PG8_LDB(B1, 0, 1); PG8_SCHED; PG8_LDA(At, 0, 0); PG8_STAGE(PG8_SA(1, 1), a1 + hstep, voffA);
            PG8_WAIT_V(8); PG8_WAIT_L(0); PG8_BAR; PG8_MMA(0, 0, At, B0); PG8_MMA(0, 1, At, B1); PG8_BAR; PG8_SCHED;
            PG8_LDA(At, 0, 1); PG8_STAGE(PG8_SB(0, 0), b2, voffB); PG8_STAGE(PG8_SB(0, 1), b2 + hstep, voffB); PG8_STAGE(PG8_SA(0, 0), a2, voffA);
            PG8_WAIT_V(8); PG8_WAIT_L(0); PG8_BAR; PG8_MMA(1, 0, At, B0); PG8_MMA(1, 1, At, B1); PG8_BAR; PG8_SCHED;
            PG8_LDB(B0, 1, 0); PG8_LDB(B1, 1, 1); PG8_SCHED; PG8_LDA(At, 1, 0); PG8_STAGE(PG8_SA(0, 1), a2 + hstep, voffA);
            PG8_WAIT_V(8); PG8_WAIT_L(0); PG8_BAR; PG8_MMA(0, 0, At, B0); PG8_MMA(0, 1, At, B1); PG8_BAR; PG8_SCHED;
            PG8_LDA(At, 1, 1); PG8_STAGE(PG8_SB(1, 0), b3, voffB); PG8_STAGE(PG8_SB(1, 1), b3 + hstep, voffB); PG8_STAGE(PG8_SA(1, 0), a3, voffA);
            PG8_WAIT_V(8); PG8_WAIT_L(0); PG8_BAR; PG8_MMA(1, 0, At, B0); PG8_MMA(1, 1, At, B1); PG8_BAR; PG8_SCHED;
            } else {
            PG8_LDB(B0, 0, 0); PG8_SCHED; PG8_LDA(At, 0, 0); PG8_STAGE(PG8_SA(1, 1), a1 + hstep, voffA);
            PG8_WAIT_L(8); PG8_BAR; PG8_WAIT_L(0); PG8_MMA(0, 0, At, B0); PG8_BAR; PG8_SCHED;
            PG8_LDB(B1, 0, 1); PG8_STAGE(PG8_SB(0, 0), b2, voffB);
            PG8_BAR; PG8_WAIT_L(0); PG8_MMA(0, 1, At, B1); PG8_BAR;
            PG8_LDA(At, 0, 1); PG8_STAGE(PG8_SA(0, 0), a2, voffA);
            PG8_BAR; PG8_WAIT_L(0); PG8_MMA(1, 0, At, B0); PG8_BAR; PG8_SCHED;
            PG8_STAGE(PG8_SB(0, 1), b2 + hstep, voffB);
            PG8_WAIT_V(6); PG8_BAR; PG8_MMA(1, 1, At, B1); PG8_BAR;
            PG8_LDB(B0, 1, 0); PG8_SCHED; PG8_LDA(At, 1, 0); PG8_STAGE(PG8_SA(0, 1), a2 + hstep, voffA);
            PG8_WAIT_L(8); PG8_BAR; PG8_WAIT_L(0); PG8_MMA(0, 0, At, B0); PG8_BAR; PG8_SCHED;
            PG8_LDB(B1, 1, 1); PG8_STAGE(PG8_SB(1, 0), b3, voffB);
            PG8_BAR; PG8_WAIT_L(0); PG8_MMA(0, 1, At, B1); PG8_BAR;
            PG8_LDA(At, 1, 1); PG8_STAGE(PG8_SA(1, 0), a3, voffA);
            PG8_BAR; PG8_WAIT_L(0); PG8_MMA(1, 0, At, B0); PG8_BAR; PG8_SCHED;
            PG8_STAGE(PG8_SB(1, 1), b3 + hstep, voffB);
            PG8_WAIT_V(6); PG8_BAR; PG8_MMA(1, 1, At, B1); PG8_BAR;
            }
        }
        if constexpr (ALIGN_EPI) { if (wr == 0) PG8_BAR; }
        if constexpr (!Epi::AFTER_DRAIN) { E(acc, cur, wr, wc, fr, fq); S.done(cur); }
        if (!has_next) break;
#pragma unroll
        for (int a = 0; a < 2; ++a)
#pragma unroll
            for (int b = 0; b < 2; ++b)
#pragma unroll
                for (int m = 0; m < 4; ++m)
#pragma unroll
                    for (int n = 0; n < 2; ++n) acc[a][b][m][n] = (f32x4){0.f, 0.f, 0.f, 0.f};
        cur = nxt; cA = nA; cB = nB; ++ui;
        if constexpr (ALIGN_EPI) { if (wr == 1) PG8_BAR; }
    }
    PG8_WAIT_V(0);
    if constexpr (!ALIGN_EPI) { if (wr == 0) PG8_BAR; }
    PG8_BAR;
    if constexpr (Epi::AFTER_DRAIN) { E.fused(acc, cur, wr, wc, fr, fq, lds, wid, lane); S.done(cur); }
#undef PG8_SA
#undef PG8_SB
#undef PG8_STAGE
#undef PG8_LDA
#undef PG8_LDB
#undef PG8_MMA
#undef PG8_WAIT_V
#undef PG8_WAIT_L
#undef PG8_BAR
#undef PG8_SCHED
}
}
#define LAS __attribute__((address_space(3)))
#define DI_ __device__ __forceinline__
typedef unsigned short bf16_t;
typedef short bf16x8 __attribute__((ext_vector_type(8)));
typedef float f32x4 __attribute__((ext_vector_type(4)));
typedef float f32x2 __attribute__((ext_vector_type(2)));
typedef float f32x16 __attribute__((ext_vector_type(16)));
typedef unsigned u32x4 __attribute__((ext_vector_type(4)));
typedef unsigned u32x2 __attribute__((ext_vector_type(2)));
typedef __bf16 hbf2 __attribute__((ext_vector_type(2)));

constexpr int T = 16384, DM = 1024, DI = 2048, SEQ = 4096, NB = 4, NH = 16;
constexpr float EPS = 1e-6f;
constexpr float LOG2E = 1.4426950408889634f, LN2 = 0.6931471805599453f;
constexpr size_t MiB = 1u << 20;
constexpr size_t WS_WB = 1 * MiB, WS_H = 22 * MiB, WS_Q = 54 * MiB, WS_K = 118 * MiB, WS_VT = 182 * MiB, WS_CS = 246 * MiB, WS_LF = 250 * MiB, WS_CUM = 251 * MiB, WS_END = 252 * MiB;
constexpr size_t WS_O = WS_Q, WS_LAT = WS_Q, WS_QG = 118 * MiB  , WS_KL = 214 * MiB  , WS_KVNT = 220 * MiB  , WS_QN = 228 * MiB, WS_KVN = 236 * MiB;
constexpr size_t WB_IN = 0, WB_O = (size_t)8192 * 1024;
constexpr size_t WB1_LAT = 0, WB1_G = (size_t)448 * 1024  , WB1_Q = WB1_G + (size_t)2048 * 1024, WB1_K = WB1_Q + (size_t)3072 * 256, WB1_V = WB1_K + (size_t)2048 * 128, WB1_O = WB1_V + (size_t)2048 * 128;
constexpr int LDS_CTL_OFF = 147456, LDS_BYTES = LDS_CTL_OFF + 1024;
constexpr int NPH = 23;

DI_ unsigned pk2(float a, float b) { f32x2 v = {a, b}; hbf2 r = __builtin_convertvector(v, hbf2); return __builtin_bit_cast(unsigned, r); }
DI_ float bf_lo(unsigned u) { return __uint_as_float(u << 16); }
DI_ float bf_hi(unsigned u) { return __uint_as_float(u & 0xffff0000u); }
template <int CTRL> DI_ float dpp_add(float v) { return v + __int_as_float(__builtin_amdgcn_update_dpp(0, __float_as_int(v), CTRL, 0xF, 0xF, true)); }
DI_ float wave_sum(float v) {
    v = dpp_add<0xB1>(v);
    v = dpp_add<0x4E>(v);
    v = dpp_add<0x141>(v);
    v = dpp_add<0x140>(v);
    const int iv = __float_as_int(v);
    const float r0 = __int_as_float(__builtin_amdgcn_readlane(iv, 0)), r1 = __int_as_float(__builtin_amdgcn_readlane(iv, 16)), r2 = __int_as_float(__builtin_amdgcn_readlane(iv, 32)), r3 = __int_as_float(__builtin_amdgcn_readlane(iv, 48));
    return (r0 + r1) + (r2 + r3);
}
DI_ float silu_f(float x) { return x * __builtin_amdgcn_rcpf(1.0f + __builtin_amdgcn_exp2f(-x * LOG2E)); }
#define LDS_WAIT() asm volatile("s_waitcnt lgkmcnt(0)" ::: "memory")

namespace pg8 {
struct EpiBf16K {
    static constexpr bool PERM = true, AFTER_DRAIN = false;
    bf16_t* O; int ldc; int split_cols; size_t split_stride; float* knp;
    __device__ __forceinline__ void operator()(const f32x4 (&acc)[2][2][4][2], const Unit& u, int wr, int wc, int fr, int fq) const {
        const int row0 = u.pm * BM + wr * 64 + fr; int colt = u.pn * BM; bf16_t* base = O; int t = 0;
        if (split_cols) { t = colt / split_cols; base += (size_t)t * split_stride; colt -= t * split_cols; }
        const int col0 = colt + wc * 32 + 8 * fq;
        const bool kn = knp != nullptr && t == 1;
#pragma unroll
        for (int ai = 0; ai < 2; ++ai)
#pragma unroll
            for (int m = 0; m < 4; ++m) { const int row = row0 + ai * HALF + m * 16; bf16_t* rowp = base + (size_t)row * ldc + col0;
#pragma unroll
                for (int bj = 0; bj < 2; ++bj) { const f32x4 v0 = acc[ai][bj][m][0], v1 = acc[ai][bj][m][1];
                    u32x4 w; w.x = ::pk2(v0[0], v0[1]); w.y = ::pk2(v0[2], v0[3]); w.z = ::pk2(v1[0], v1[1]); w.w = ::pk2(v1[2], v1[3]);
                    *(u32x4*)(rowp + bj * HALF) = w;
                    if (kn) { float ss = ((v0[0] * v0[0] + v0[1] * v0[1]) + (v0[2] * v0[2] + v0[3] * v0[3])) + ((v1[0] * v1[0] + v1[1] * v1[1]) + (v1[2] * v1[2] + v1[3] * v1[3]));
                        ss += __shfl_xor(ss, 16); ss += __shfl_xor(ss, 32);
                        if (fq == 0) knp[((size_t)((row >> 12) * 16 + (colt >> 7) + bj) * 4096 + (row & 4095)) * 4 + wc] = ss; } } }
    }
};
struct EpiGate {
    static constexpr bool PERM = true, AFTER_DRAIN = false;
    bf16_t* O; int ldc;
    __device__ __forceinline__ void operator()(const f32x4 (&acc)[2][2][4][2], const Unit& u, int wr, int wc, int fr, int fq) const {
        const int row0 = u.pm * BM + wr * 64 + fr, col0 = u.pn * BM + wc * 32 + 8 * fq;
#pragma unroll
        for (int ai = 0; ai < 2; ++ai)
#pragma unroll
            for (int m = 0; m < 4; ++m) { bf16_t* rowp = O + (size_t)(row0 + ai * HALF + m * 16) * ldc + col0;
#pragma unroll
                for (int bj = 0; bj < 2; ++bj) { const f32x4 v0 = acc[ai][bj][m][0], v1 = acc[ai][bj][m][1];
                    const u32x4 ov = *(const u32x4*)(rowp + bj * HALF); u32x4 w;
                    w.x = ::pk2(::bf_lo(ov.x) * ::silu_f(v0[0]), ::bf_hi(ov.x) * ::silu_f(v0[1]));
                    w.y = ::pk2(::bf_lo(ov.y) * ::silu_f(v0[2]), ::bf_hi(ov.y) * ::silu_f(v0[3]));
                    w.z = ::pk2(::bf_lo(ov.z) * ::silu_f(v1[0]), ::bf_hi(ov.z) * ::silu_f(v1[1]));
                    w.w = ::pk2(::bf_lo(ov.w) * ::silu_f(v1[2]), ::bf_hi(ov.w) * ::silu_f(v1[3]));
                    *(u32x4*)(rowp + bj * HALF) = w; } }
    }
};
template <bool HASBASE> struct EpiF32 {
    static constexpr bool PERM = false, AFTER_DRAIN = false;
    const float* base; float* out; int ldc;
    __device__ __forceinline__ void operator()(const f32x4 (&acc)[2][2][4][2], const Unit& u, int wr, int wc, int fr, int fq) const {
        const int row0 = u.pm * BM + wr * 64 + fr, col0 = u.pn * BM + wc * 32 + 4 * fq;
#pragma unroll
        for (int ai = 0; ai < 2; ++ai)
#pragma unroll
            for (int m = 0; m < 4; ++m) { const size_t off = (size_t)(row0 + ai * HALF + m * 16) * ldc + col0;
#pragma unroll
                for (int bj = 0; bj < 2; ++bj)
#pragma unroll
                    for (int n = 0; n < 2; ++n) { f32x4 v = acc[ai][bj][m][n]; if constexpr (HASBASE) v += *(const f32x4*)(base + off + bj * HALF + n * 16); *(f32x4*)(out + off + bj * HALF + n * 16) = v; } }
    }
};
}

DI_ void tr_item(const float* W, int ldw, int K, int k0, int col0, bf16_t* WT, int row0, LAS float* scr, int lane) {
#pragma unroll 8
    for (int i = 0; i < 32; ++i) { const int kk = 2 * i + (lane >> 5); scr[kk * 33 + (lane & 31)] = W[(size_t)(k0 + kk) * ldw + col0 + (lane & 31)]; }
    LDS_WAIT();
    const int c = lane & 7;
#pragma unroll
    for (int j = 0; j < 4; ++j) { const int n = (lane >> 3) + 8 * j; const LAS float* s = scr + (8 * c) * 33 + n;
        u32x4 o; o.x = pk2(s[0 * 33], s[1 * 33]); o.y = pk2(s[2 * 33], s[3 * 33]); o.z = pk2(s[4 * 33], s[5 * 33]); o.w = pk2(s[6 * 33], s[7 * 33]);
        *(u32x4*)(WT + (size_t)(row0 + n) * K + k0 + 8 * c) = o; }
    LDS_WAIT();
}
DI_ void conv_seg(const float* W, int ldw, int K, int col_start, int ncols, bf16_t* WT, int row_start, LAS float* scr, int gw, int NGW, int lane) {
    const int nblk = ncols / 32, nitems = (K / 64) * nblk;
    for (int it = gw; it < nitems; it += NGW) { const int kb = it / nblk, nb = it - kb * nblk; tr_item(W, ldw, K, 64 * kb, col_start + 32 * nb, WT, row_start + 32 * nb, scr, lane); }
}
#define XB_TMO      128
#define XB_XCNT(j)  (256  + 64 * (j))
#define XB_XSUB(j)  (1280 + 64 * (j))
#define XB_XGEN(j)  (2304 + 64 * (j))
#define XB_TOP      3328
#define XB_TOPGEN   3392
#define XCD_BAR_WORDS 3456
#define XB_SPIN_CAP (1u << 18)

__device__ __forceinline__ unsigned xb_ld(unsigned* p)              { return __hip_atomic_load(p, __ATOMIC_RELAXED, __HIP_MEMORY_SCOPE_AGENT); }
__device__ __forceinline__ unsigned xb_add(unsigned* p, unsigned v) { return __hip_atomic_fetch_add(p, v, __ATOMIC_RELAXED, __HIP_MEMORY_SCOPE_AGENT); }
__device__ __forceinline__ unsigned xb_xcc_id() { return (unsigned)__builtin_amdgcn_s_getreg((3 << 11) | 20) & 0xFu; }
#define XB_SPIN(cond, bar) do { unsigned _sp = 0; while (cond) { __builtin_amdgcn_s_sleep(1); \
    if ((++_sp & 255u) == 0u) { if (xb_ld(&(bar)[XB_TMO])) break; if (_sp > XB_SPIN_CAP) { atomicAdd(&(bar)[XB_TMO], 1u); break; } } } } while (0)

struct XcdBarrier {
    unsigned* bar; unsigned x;
    volatile LAS unsigned* st;
};

__device__ __forceinline__ XcdBarrier xcd_barrier_post(unsigned* bar, volatile LAS unsigned* st) {
    XcdBarrier b; b.bar = bar; b.x = xb_xcc_id(); b.st = st;
    if (threadIdx.x == 0) (void)xb_add(&bar[XB_XCNT(b.x)], 1u);
    return b;
}
__device__ __forceinline__ void xcd_barrier_complete(unsigned* bar, unsigned x, unsigned& nloc, unsigned& nx) {
    const unsigned G = gridDim.x * gridDim.y * gridDim.z;
    unsigned sum, cnt, mine, sp = 0u;
    for (;;) {
        sum = 0u; cnt = 0u; mine = 0u;
#pragma unroll
        for (unsigned j = 0; j < 16; ++j) { const unsigned c = xb_ld(&bar[XB_XCNT(j)]); sum += c; cnt += (c > 0u) ? 1u : 0u; mine = (j == x) ? c : mine; }
        if (sum == G) break;
        __builtin_amdgcn_s_sleep(1);
        if ((++sp & 255u) == 0u) { if (xb_ld(&bar[XB_TMO])) break; if (sp > XB_SPIN_CAP) { atomicAdd(&bar[XB_TMO], 1u); break; } }
    }
    nloc = mine > 0u ? mine : 1u; nx = cnt > 0u ? cnt : 1u;
}

__device__ __forceinline__ void xcd_barrier(const XcdBarrier& b) {
    asm volatile("s_waitcnt vmcnt(0)" ::: "memory");
    __syncthreads();
    if (threadIdx.x == 0) {
        unsigned* bar = b.bar;
        __builtin_amdgcn_s_waitcnt(0);
        unsigned nloc = b.st[0], nx = b.st[1];
        if (nloc == 0u) { xcd_barrier_complete(bar, b.x, nloc, nx); b.st[0] = nloc; b.st[1] = nx; }
        const unsigned old = xb_add(&bar[XB_XSUB(b.x)], 1u);
        const unsigned gen = old / nloc;
        if (old + 1u == (gen + 1u) * nloc) {
            __builtin_amdgcn_fence(__ATOMIC_RELEASE, "agent");
            asm volatile("s_waitcnt vmcnt(0)" ::: "memory");
            const unsigned og = xb_add(&bar[XB_TOP], 1u);
            const unsigned tg = og / nx;
            if (og + 1u == (tg + 1u) * nx) xb_add(&bar[XB_TOPGEN], 1u);
            else XB_SPIN(xb_ld(&bar[XB_TOPGEN]) == tg, bar);
            __builtin_amdgcn_fence(__ATOMIC_ACQUIRE, "agent");
            xb_add(&bar[XB_XGEN(b.x)], 1u);
            asm volatile("s_waitcnt vmcnt(0)" ::: "memory");
        } else {
            XB_SPIN(xb_ld(&bar[XB_XGEN(b.x)]) == gen, bar);
            __builtin_amdgcn_fence(__ATOMIC_ACQUIRE, "agent");
            asm volatile("s_waitcnt vmcnt(0)" ::: "memory");
        }
    }
    __syncthreads();
}
struct AttnP { const bf16_t* Q; const bf16_t* K; const bf16_t* KR; const bf16_t* VT; bf16_t* O; const float* cum; const float* cs; const float* kn2; const bf16_t* WV; int qpitch, kpitch, opitch, nh, khead, krpitch, vheadrows; };
#define MFMA32(a, b, c) __builtin_amdgcn_mfma_f32_32x32x16_bf16((a), (b), (c), 0, 0, 0)
DI_ bf16x8 pack8(float a0, float a1, float a2, float a3, float a4, float a5, float a6, float a7) {
    u32x4 w = {pk2(a0, a1), pk2(a2, a3), pk2(a4, a5), pk2(a6, a7)}; return __builtin_bit_cast(bf16x8, w);
}
DI_ float xhalf(float x) { const auto r = __builtin_amdgcn_permlane32_swap(__float_as_uint(x), __float_as_uint(x), false, false); return __uint_as_float((threadIdx.x & 32) ? r[0] : r[1]); }

DI_ void stick_half(f32x16& p, float& R, const bool diag, const int dqh, const int hi, const float C2) {
    float ls[16];
    if (diag) {
#pragma unroll
        for (int r = 0; r < 16; ++r) { const int kk = (r & 3) + 8 * (r >> 2) + 4 * hi; if (!(kk < dqh)) p[r] = -__builtin_inff(); }
    }
#pragma unroll
    for (int r = 0; r < 16; ++r) { const float z = __builtin_amdgcn_fmed3f(p[r] * C2, -150.f, 126.f), sp = __builtin_amdgcn_logf(1.0f + __builtin_amdgcn_exp2f(z)); ls[r] = -sp; p[r] = z - sp; }
    float gs[4], ps[4], tot[4];
#pragma unroll
    for (int g = 0; g < 4; ++g) { gs[g] = (ls[4 * g] + ls[4 * g + 1]) + (ls[4 * g + 2] + ls[4 * g + 3]); ps[g] = xhalf(gs[g]); tot[g] = gs[g] + ps[g]; }
    float suf = 0.f;
#pragma unroll
    for (int g = 3; g >= 0; --g) {
        const float l3 = R + suf + (hi == 0 ? ps[g] : 0.f), l2 = l3 + ls[4 * g + 3], l1 = l2 + ls[4 * g + 2], l0 = l1 + ls[4 * g + 1];
        p[4 * g + 3] = __builtin_amdgcn_exp2f(p[4 * g + 3] + l3); p[4 * g + 2] = __builtin_amdgcn_exp2f(p[4 * g + 2] + l2);
        p[4 * g + 1] = __builtin_amdgcn_exp2f(p[4 * g + 1] + l1); p[4 * g] = __builtin_amdgcn_exp2f(p[4 * g] + l0);
        suf += tot[g];
    }
    R += suf;
}

template <int MODE>
DI_ void attn_unit(LAS unsigned char* lds, const AttnP& P, const int b, const int hh, const int qb) {
    constexpr int DK = MODE == 1 ? 192 : 128, NKS = DK / 16, KROW = DK * 2, KT_BYTES = 64 * KROW, VSTR = 144, VT_BYTES = 128 * VSTR;
    constexpr int CT_OFF = KT_BYTES + VT_BYTES, BUF = CT_OFF + 256, FLAG_OFF = 2 * BUF;
    int tid_ = threadIdx.x; asm volatile("" : "+v"(tid_));
    const int tid = tid_, wid = __builtin_amdgcn_readfirstlane(tid >> 6), lane = tid & 63, r32 = lane & 31, hi = lane >> 5;
    const int q0 = qb * 256, tq = q0 + wid * 32 + r32;
    const size_t tokq = (size_t)b * SEQ + tq;
    constexpr float SCALE = MODE == 1 ? 0.07216878364870322f : 0.08838834764831845f;
    constexpr float C2 = SCALE * LOG2E;
    bf16x8 qr[NKS];
    { const bf16_t* qp = P.Q + tokq * P.qpitch + hh * DK + hi * 8;
#pragma unroll
      for (int d0 = 0; d0 < NKS; ++d0) qr[d0] = *(const bf16x8*)(qp + d0 * 16); }
    if constexpr (MODE == 1) {
#pragma unroll
        for (int dd = 0; dd < 2; ++dd) {
            const float* cp = P.cs + tokq * 32 + 16 * dd + 8 * hi; const float* sp = cp + (size_t)T * 32;
            const f32x4 c0 = *(const f32x4*)cp, c1 = *(const f32x4*)(cp + 4), s0 = *(const f32x4*)sp, s1 = *(const f32x4*)(sp + 4);
            const u32x4 a = __builtin_bit_cast(u32x4, qr[8 + dd]), bb = __builtin_bit_cast(u32x4, qr[10 + dd]);
            float x1[8] = {bf_lo(a.x), bf_hi(a.x), bf_lo(a.y), bf_hi(a.y), bf_lo(a.z), bf_hi(a.z), bf_lo(a.w), bf_hi(a.w)};
            float x2[8] = {bf_lo(bb.x), bf_hi(bb.x), bf_lo(bb.y), bf_hi(bb.y), bf_lo(bb.z), bf_hi(bb.z), bf_lo(bb.w), bf_hi(bb.w)};
            float cc[8] = {c0[0], c0[1], c0[2], c0[3], c1[0], c1[1], c1[2], c1[3]}, ss[8] = {s0[0], s0[1], s0[2], s0[3], s1[0], s1[1], s1[2], s1[3]};
            float y1[8], y2[8];
#pragma unroll
            for (int i = 0; i < 8; ++i) { y1[i] = x1[i] * cc[i] - x2[i] * ss[i]; y2[i] = x1[i] * ss[i] + x2[i] * cc[i]; }
            qr[8 + dd] = pack8(y1[0], y1[1], y1[2], y1[3], y1[4], y1[5], y1[6], y1[7]);
            qr[10 + dd] = pack8(y2[0], y2[1], y2[2], y2[3], y2[4], y2[5], y2[6], y2[7]);
        }
    }
    const bf16_t* Kg = P.K + (size_t)b * SEQ * P.kpitch + hh * P.khead;
    const bf16_t* VTg = P.VT + (size_t)(hh * P.vheadrows) * T + (size_t)b * SEQ;
    const int krow = tid >> 4, kc = tid & 15;
    const int ksw = MODE == 1 ? krow * KROW + ((kc ^ ((((krow >> 1) & 1) << 2) | ((krow >> 2) & 3))) << 4) : krow * KROW + ((kc ^ (krow & 15)) << 4);
    const int rrow = tid >> 3, rc = tid & 7;
    const int rsw = rrow * KROW + (((16 + rc) ^ ((((rrow >> 1) & 1) << 2) | ((rrow >> 2) & 3))) << 4);
    const int vrow = tid >> 3, vc = tid & 7;
    const int vsw = KT_BYTES + vrow * VSTR + (vc >> 1) * 32 + (vc & 1) * 8;
    const int kfb = MODE == 1 ? r32 * KROW : r32 * KROW + ((hi ^ (r32 & 15)) << 4);
    const int kg16 = (hi ^ ((((r32 >> 1) & 1) << 2) | ((r32 >> 2) & 3))) << 4;
    const int vfb = KT_BYTES + r32 * VSTR + hi * 16;
    float m_run = -1e30f, l_run = 0.f, R = 0.f;
    f32x16 o[4];
#pragma unroll
    for (int d = 0; d < 4; ++d)
#pragma unroll
        for (int r = 0; r < 16; ++r) o[d][r] = 0.f;
    const int jd = (q0 >> 6) + (wid >> 1), jtop = (q0 >> 6) + 3;
    const int dq = (wid & 1) * 32 + r32;
    constexpr bool DESC = MODE != 1;
    int j = DESC ? jtop : 0;
    bf16x8 sk0, sk1, skr, sv0, sv1; float scv = 0.f;
#define A_GLOAD(jj) do { const bf16_t* kp = Kg + (size_t)((jj) * 64 + krow) * P.kpitch + kc * 8; sk0 = *(const bf16x8*)kp; sk1 = *(const bf16x8*)(kp + (size_t)32 * P.kpitch); \
        if constexpr (MODE == 1) skr = *(const bf16x8*)(P.KR + ((size_t)b * SEQ + (jj) * 64 + rrow) * P.krpitch + rc * 8); \
        if constexpr (MODE != 1) { const bf16_t* vp = VTg + (size_t)vrow * T + (jj) * 64 + vc * 8; sv0 = *(const bf16x8*)vp; sv1 = *(const bf16x8*)(vp + (size_t)64 * T); } \
        if constexpr (MODE == 2) { if (tid < 64) scv = P.cum[((size_t)b * NH + hh) * SEQ + (jj) * 64 + tid]; } } while (0)
#define A_SWRITE(bufi) do { LAS unsigned char* bp = lds + (bufi) * BUF; *(LAS bf16x8*)(bp + ksw) = sk0; *(LAS bf16x8*)(bp + ksw + 32 * KROW) = sk1; \
        if constexpr (MODE == 1) *(LAS bf16x8*)(bp + rsw) = skr; \
        if constexpr (MODE != 1) { const u32x4 a = __builtin_bit_cast(u32x4, sv0), c = __builtin_bit_cast(u32x4, sv1); \
          *(LAS u32x2*)(bp + vsw) = (u32x2){a.x, a.y}; *(LAS u32x2*)(bp + vsw + 16) = (u32x2){a.z, a.w}; \
          *(LAS u32x2*)(bp + vsw + 64 * VSTR) = (u32x2){c.x, c.y}; *(LAS u32x2*)(bp + vsw + 64 * VSTR + 16) = (u32x2){c.z, c.w}; } \
        if constexpr (MODE == 2) { if (tid < 64) *(LAS float*)(bp + CT_OFF + tid * 4) = scv; } } while (0)
    float bound_t = 0.f;
    if constexpr (MODE != 0) {
        float km = 0.f;
        if constexpr (MODE == 2) { const f32x4* kn = (const f32x4*)P.kn2 + ((size_t)b * NH + hh) * SEQ;
            for (int i = tid; i < q0 + 256; i += 512) { const f32x4 v = kn[i]; km = fmaxf(km, (v.x + v.y) + (v.z + v.w)); } }
        else { const float* kn = P.kn2 + (size_t)b * SEQ;
            for (int i = tid; i < q0 + 256; i += 512) km = fmaxf(km, kn[i]); }
#pragma unroll
        for (int o_ = 1; o_ < 64; o_ <<= 1) km = fmaxf(km, __shfl_xor(km, o_));
        if (lane == 0) *(LAS float*)(lds + FLAG_OFF + 64 + wid * 4) = km;
        float q2 = 0.f;
#pragma unroll
        for (int d0 = 0; d0 < NKS; ++d0) { const u32x4 a = __builtin_bit_cast(u32x4, qr[d0]);
            q2 += (bf_lo(a.x) * bf_lo(a.x) + bf_hi(a.x) * bf_hi(a.x)) + (bf_lo(a.y) * bf_lo(a.y) + bf_hi(a.y) * bf_hi(a.y)) + (bf_lo(a.z) * bf_lo(a.z) + bf_hi(a.z) * bf_hi(a.z)) + (bf_lo(a.w) * bf_lo(a.w) + bf_hi(a.w) * bf_hi(a.w)); }
        q2 += xhalf(q2);
        bound_t = q2;
    }
    A_GLOAD(j); A_SWRITE(0);
    if (DESC ? (j > 0) : (j < jtop)) A_GLOAD(DESC ? j - 1 : j + 1);
    __syncthreads();
    if constexpr (MODE != 0) { const f32x4 k0 = *(const LAS f32x4*)(lds + FLAG_OFF + 64), k1 = *(const LAS f32x4*)(lds + FLAG_OFF + 80);
        const float km2 = fmaxf(fmaxf(fmaxf(k0.x, k0.y), fmaxf(k0.z, k0.w)), fmaxf(fmaxf(k1.x, k1.y), fmaxf(k1.z, k1.w)));
        bound_t = sqrtf(bound_t * km2) * (C2 * 1.02f); }
    float nck_t = 0.f;
    if constexpr (MODE == 2) nck_t = P.cum[((size_t)b * NH + hh) * SEQ + tq];
    bool wdone = false;
    for (int it = 0;; ++it) {
        const int cur = it & 1;
        const int jn = DESC ? j - 1 : j + 1;
        const bool pre = DESC ? (j > 0) : (j < jtop);
        const bool act = (j <= jd) && !wdone;
        if (act) {
            const LAS unsigned char* bp = lds + cur * BUF;
            f32x16 p0, p1;
#pragma unroll
            for (int r = 0; r < 16; ++r) { p0[r] = 0.f; p1[r] = 0.f; }
            {
                bf16x8 kf[3][2];
#define A_KLD(d0_) do { const int ka_ = MODE == 1 ? kfb + (((d0_) << 5) ^ kg16) : (kfb ^ ((d0_) << 5)); kf[(d0_) % 3][0] = *(const LAS bf16x8*)(bp + ka_); kf[(d0_) % 3][1] = *(const LAS bf16x8*)(bp + ka_ + 32 * KROW); } while (0)
                A_KLD(0); A_KLD(1);
#pragma unroll
                for (int d0 = 0; d0 < NKS; ++d0) {
                    if (d0 + 2 < NKS) A_KLD(d0 + 2);
                    p0 = MFMA32(kf[d0 % 3][0], qr[d0], p0); p1 = MFMA32(kf[d0 % 3][1], qr[d0], p1);
                }
#undef A_KLD
                __builtin_amdgcn_sched_group_barrier(0x100, 4, 0);
#pragma unroll
                for (int d0 = 0; d0 < NKS - 2; ++d0) { __builtin_amdgcn_sched_group_barrier(0x100, 2, 0); __builtin_amdgcn_sched_group_barrier(0x008, 2, 0); }
                __builtin_amdgcn_sched_group_barrier(0x008, 4, 0);
            }
            const bool diag = (j == jd);
            if constexpr (MODE == 0) {
                stick_half(p1, R, diag, dq - 32, hi, C2);
                __builtin_amdgcn_sched_barrier(0);
                stick_half(p0, R, diag, dq, hi, C2);
                wdone = __all(R < -46.0f) != 0;
            } else {
                if constexpr (MODE == 2) {
#pragma unroll
                    for (int g = 0; g < 4; ++g) {
                        const f32x4 ck0 = *(const LAS f32x4*)(bp + CT_OFF + g * 32 + hi * 16), ck1 = *(const LAS f32x4*)(bp + CT_OFF + 128 + g * 32 + hi * 16);
#pragma unroll
                        for (int e = 0; e < 4; ++e) { const int r = 4 * g + e, kk = 8 * g + 4 * hi + e;
                            float y0 = fmaf(p0[r], C2, ck0[e]), y1 = fmaf(p1[r], C2, ck1[e]);
                            if (diag) { if (kk > dq) y0 = -__builtin_inff(); if (kk + 32 > dq) y1 = -__builtin_inff(); }
                            p0[r] = y0; p1[r] = y1; }
                    }
                }
                if constexpr (MODE == 2) m_run = bound_t + nck_t;
                if constexpr (MODE != 0) {
                    if constexpr (MODE == 1) m_run = bound_t;
                } else {
                float pmax = fmaxf(p0[0], p1[0]);
#pragma unroll
                for (int r = 1; r < 16; ++r) pmax = fmaxf(pmax, fmaxf(p0[r], p1[r]));
                pmax = fmaxf(pmax, xhalf(pmax));
                if (!__all(pmax - m_run <= 8.0f)) {
                    const float mn = fmaxf(m_run, pmax), alpha = __builtin_amdgcn_exp2f(m_run - mn);
                    m_run = mn; l_run *= alpha;
#pragma unroll
                    for (int d = 0; d < 4; ++d)
#pragma unroll
                        for (int r = 0; r < 16; ++r) o[d][r] *= alpha;
                }
                }
                float ps0 = 0.f, ps1 = 0.f;
#pragma unroll
                for (int r = 0; r < 16; ++r) {
                    if constexpr (MODE == 1) { p0[r] = __builtin_amdgcn_exp2f(fmaf(p0[r], C2, -m_run)); p1[r] = __builtin_amdgcn_exp2f(fmaf(p1[r], C2, -m_run)); }
                    else { p0[r] = __builtin_amdgcn_exp2f(p0[r] - m_run); p1[r] = __builtin_amdgcn_exp2f(p1[r] - m_run); }
                    ps0 += p0[r]; ps1 += p1[r]; }
                l_run += ps0 + ps1;
                if constexpr (MODE == 2) {
                    const float nck0 = *(const LAS float*)(bp + CT_OFF);
                    wdone = __all((nck0 - nck_t) - __builtin_amdgcn_logf(l_run + xhalf(l_run)) < -56.0f) != 0;
                }
            }
            bf16x8 pb[4];
            pb[0] = pack8(p0[0], p0[1], p0[2], p0[3], p0[4], p0[5], p0[6], p0[7]); pb[1] = pack8(p0[8], p0[9], p0[10], p0[11], p0[12], p0[13], p0[14], p0[15]);
            pb[2] = pack8(p1[0], p1[1], p1[2], p1[3], p1[4], p1[5], p1[6], p1[7]); pb[3] = pack8(p1[8], p1[9], p1[10], p1[11], p1[12], p1[13], p1[14], p1[15]);
            {
                bf16x8 vf[5];
                typedef short s16x4_ __attribute__((ext_vector_type(4)));
                const int trq = (lane & 15) >> 2, trp = lane & 3, trg = (lane >> 4) & 1, trqh = trq >> 1;
                const int trl0 = (((2 * trg + (trp >> 1)) ^ hi) << 4) | ((trp & 1) * 8), trl1 = (((2 * trg + (trp >> 1)) ^ hi ^ 2) << 4) | ((trp & 1) * 8);
                const int trE = (4 * hi + trq) * KROW + trqh * 64, trO = (4 * hi + trq) * KROW - trqh * 64;
#define A_VLD_TR(i_) do { const int cb_ = (((i_) & 1) ? trO : trE) + ((i_) >> 2) * 16 * KROW + ((i_) & 3) * 64; \
                    const s16x4_ t0_ = __builtin_amdgcn_ds_read_tr16_b64_v4i16((LAS s16x4_*)(bp + cb_ + trl0)); \
                    const s16x4_ t1_ = __builtin_amdgcn_ds_read_tr16_b64_v4i16((LAS s16x4_*)(bp + cb_ + 8 * KROW + trl1)); \
                    vf[(i_) % 5] = (bf16x8){t0_[0], t0_[1], t0_[2], t0_[3], t1_[0], t1_[1], t1_[2], t1_[3]}; } while (0)
#define A_VLD(i_) do { if constexpr (MODE == 1) A_VLD_TR(i_); else vf[(i_) % 5] = *(const LAS bf16x8*)(bp + vfb + ((i_) & 3) * 32 * VSTR + ((i_) >> 2) * 32); } while (0)
                A_VLD(0); A_VLD(1); A_VLD(2); A_VLD(3);
#pragma unroll
                for (int i = 0; i < 16; ++i) {
                    if (i + 4 < 16) A_VLD(i + 4);
                    o[i & 3] = MFMA32(vf[i % 5], pb[i >> 2], o[i & 3]);
                }
#undef A_VLD
#undef A_VLD_TR
                constexpr int RPF = MODE == 1 ? 2 : 1;
                __builtin_amdgcn_sched_group_barrier(0x100, 4 * RPF, 1);
#pragma unroll
                for (int i = 0; i < 12; ++i) { __builtin_amdgcn_sched_group_barrier(0x100, RPF, 1); __builtin_amdgcn_sched_group_barrier(0x008, 1, 1); }
                __builtin_amdgcn_sched_group_barrier(0x008, 4, 1);
            }
        }
        if constexpr (DESC) { if (lane == 0) *(LAS unsigned*)(lds + FLAG_OFF + (cur * 8 + wid) * 4) = wdone ? 1u : 0u; }
        if (pre) { A_SWRITE(cur ^ 1);
            const int jn2 = DESC ? jn - 1 : jn + 1; if (DESC ? (jn > 0) : (jn < jtop)) A_GLOAD(jn2); }
        __syncthreads();
        bool alldone = false;
        if constexpr (DESC) { const u32x4 f0 = *(const LAS u32x4*)(lds + FLAG_OFF + cur * 32), f1 = *(const LAS u32x4*)(lds + FLAG_OFF + cur * 32 + 16);
            alldone = (f0.x & f0.y & f0.z & f0.w & f1.x & f1.y & f1.z & f1.w) != 0u; }
        if (!pre || alldone) break;
        j = jn;
    }
#undef A_GLOAD
#undef A_SWRITE
    if constexpr (MODE != 0) { const float lt = l_run + xhalf(l_run), inv = 1.0f / lt;
#pragma unroll
        for (int d = 0; d < 4; ++d)
#pragma unroll
            for (int r = 0; r < 16; ++r) o[d][r] *= inv; }
    if constexpr (MODE == 1) {
        constexpr int WSTR = 272;
        { const bf16_t* wg = P.WV + (size_t)(hh * 128) * 128;
#pragma unroll
          for (int i = 0; i < 4; ++i) { const int id = tid + 512 * i, d = id >> 4, ch = id & 15; const u32x4 a = *(const u32x4*)(wg + (size_t)d * 128 + ch * 8);
              LAS unsigned char* wp = lds + d * WSTR + (ch >> 1) * 32 + (ch & 1) * 8; *(LAS u32x2*)wp = (u32x2){a.x, a.y}; *(LAS u32x2*)(wp + 16) = (u32x2){a.z, a.w}; } }
        bf16x8 ob[4][2];
#pragma unroll
        for (int cb = 0; cb < 4; ++cb) { ob[cb][0] = pack8(o[cb][0], o[cb][1], o[cb][2], o[cb][3], o[cb][4], o[cb][5], o[cb][6], o[cb][7]); ob[cb][1] = pack8(o[cb][8], o[cb][9], o[cb][10], o[cb][11], o[cb][12], o[cb][13], o[cb][14], o[cb][15]); }
        __syncthreads();
#pragma unroll
        for (int db = 0; db < 4; ++db) { f32x16 acc;
#pragma unroll
            for (int r = 0; r < 16; ++r) acc[r] = 0.f;
#pragma unroll
            for (int cb = 0; cb < 4; ++cb)
#pragma unroll
                for (int s = 0; s < 2; ++s) { const bf16x8 av = *(const LAS bf16x8*)(lds + (db * 32 + r32) * WSTR + (cb * 2 + s) * 32 + hi * 16); acc = MFMA32(av, ob[cb][s], acc); }
            o[db] = acc; }
        __syncthreads();
    }
    {
        constexpr int OSTR = 144, OST_OFF = 88 * 1024; static_assert(FLAG_OFF + 128 <= OST_OFF && OST_OFF + 8 * 32 * OSTR <= 131072, "O slab");
        LAS unsigned char* ob = lds + OST_OFF + wid * (32 * OSTR);
        bf16_t* og = P.O + ((size_t)b * SEQ + q0 + wid * 32) * P.opitch + hh * 128;
#pragma unroll
        for (int h = 0; h < 2; ++h) {
#pragma unroll
            for (int dd = 0; dd < 2; ++dd)
#pragma unroll
                for (int g = 0; g < 4; ++g) { const int d = 2 * h + dd;
                    *(LAS u32x2*)(ob + r32 * OSTR + (dd * 32 + 8 * g + 4 * hi) * 2) = (u32x2){pk2(o[d][4 * g], o[d][4 * g + 1]), pk2(o[d][4 * g + 2], o[d][4 * g + 3])}; }
            LDS_WAIT();
#pragma unroll
            for (int i = 0; i < 4; ++i) { const int row = 8 * i + (lane >> 3), ch = lane & 7;
                const u32x4 v = *(const LAS u32x4*)(ob + row * OSTR + ch * 16);
                *(u32x4*)(og + (size_t)row * P.opitch + h * 64 + ch * 8) = v; }
            LDS_WAIT();
        }
    }
}
DI_ void stick_wave_phase(LAS unsigned char* lds, const AttnP& P, const int gw, const int NGW) {
    constexpr int WSLAB = 18432, VOFF = 8192, VROW = 320;
    constexpr float C2 = 0.08838834764831845f * LOG2E;
    int tid_ = threadIdx.x; asm volatile("" : "+v"(tid_));
    const int wid = __builtin_amdgcn_readfirstlane(tid_ >> 6), lane = tid_ & 63, r32 = lane & 31, hi = lane >> 5;
    LAS unsigned char* wl = lds + wid * WSLAB;
    const int kfb = r32 * 256 + ((hi ^ (r32 & 15)) << 4);
    const int vfb = VOFF + (4 * hi + ((lane & 15) >> 2)) * VROW + ((lane >> 4) & 1) * 32 + (lane & 3) * 8;
#define SW_UNIT(w0_) ((NGW == 2048) ? (((16 * ((w0_) >> 11) + 2 * (((w0_) >> 3) & 7) + ((((w0_) >> 3 & 255) >> 3) >> 4)) << 7) + ((((w0_) >> 3 & 255) >> 3) & 15) * 8 + ((w0_) & 7)) : (w0_))
#define SW_QLOAD(wu_) do { const int bh_ = (wu_) >> 7, rb_ = (wu_) & 127; const bf16_t* qp = P.Q + ((size_t)(bh_ >> 4) * SEQ + 32 * rb_ + r32) * P.qpitch + (bh_ & 15) * 128 + hi * 8; \
        _Pragma("unroll") for (int d0 = 0; d0 < 8; ++d0) qn[d0] = *(const bf16x8*)(qp + d0 * 16); } while (0)
    bf16x8 qn[8];
    if (gw < NB * NH * 128) { const int wu_first = SW_UNIT(gw); SW_QLOAD(wu_first); }
    for (int wu0 = gw; wu0 < NB * NH * 128; wu0 += NGW) {
        const int wu = SW_UNIT(wu0);
        const int bh = wu >> 7, rb = wu & 127, b = bh >> 4, hh = bh & 15;
        bf16x8 qr[8];
#pragma unroll
        for (int d0 = 0; d0 < 8; ++d0) qr[d0] = qn[d0];
        const bf16_t* Kg = P.K + (size_t)b * SEQ * P.kpitch + hh * 128;
        const bf16_t* Vg = P.VT + (size_t)b * SEQ * P.kpitch + hh * 128;
        f32x16 o[4];
#pragma unroll
        for (int d = 0; d < 4; ++d)
#pragma unroll
            for (int r = 0; r < 16; ++r) o[d][r] = 0.f;
        float R = 0.f;
        for (int jt = rb; jt >= 0; --jt) {
            {
                bf16x8 ks[8], vs[8];
#pragma unroll
                for (int i = 0; i < 8; ++i) { const int id = lane + 64 * i; ks[i] = *(const bf16x8*)(Kg + (size_t)(jt * 32 + (id >> 4)) * P.kpitch + (id & 15) * 8); }
#pragma unroll
                for (int i = 0; i < 8; ++i) { const int id = lane + 64 * i; vs[i] = *(const bf16x8*)(Vg + (size_t)(jt * 32 + (id >> 4)) * P.kpitch + (id & 15) * 8); }
#pragma unroll
                for (int i = 0; i < 8; ++i) { const int id = lane + 64 * i, row = id >> 4, c = id & 15; *(LAS bf16x8*)(wl + row * 256 + ((c ^ (row & 15)) << 4)) = ks[i]; }
#pragma unroll
                for (int i = 0; i < 8; ++i) { const int id = lane + 64 * i; *(LAS bf16x8*)(wl + VOFF + (id >> 4) * VROW + (id & 15) * 16) = vs[i]; }
            }
            LDS_WAIT();
            f32x16 p;
#pragma unroll
            for (int r = 0; r < 16; ++r) p[r] = 0.f;
#pragma unroll
            for (int d0 = 0; d0 < 8; ++d0) { const bf16x8 kf = *(const LAS bf16x8*)(wl + (kfb ^ (d0 << 5))); p = MFMA32(kf, qr[d0], p); }
            stick_half(p, R, jt == rb, r32, hi, C2);
            const bf16x8 pb0 = pack8(p[0], p[1], p[2], p[3], p[4], p[5], p[6], p[7]), pb1 = pack8(p[8], p[9], p[10], p[11], p[12], p[13], p[14], p[15]);
#pragma unroll
            for (int i = 0; i < 8; ++i) {
                typedef short s16x4_ __attribute__((ext_vector_type(4)));
                const s16x4_ t0 = __builtin_amdgcn_ds_read_tr16_b64_v4i16((LAS s16x4_*)(wl + vfb + (i >> 2) * 16 * VROW + (i & 3) * 64));
                const s16x4_ t1 = __builtin_amdgcn_ds_read_tr16_b64_v4i16((LAS s16x4_*)(wl + vfb + (i >> 2) * 16 * VROW + 8 * VROW + (i & 3) * 64));
                const bf16x8 vf = {t0[0], t0[1], t0[2], t0[3], t1[0], t1[1], t1[2], t1[3]};
                o[i & 3] = MFMA32(vf, (i >> 2) ? pb1 : pb0, o[i & 3]); }
            LDS_WAIT();
            if (__all(R < -46.0f)) break;
        }
        if (wu0 + NGW < NB * NH * 128) { const int wu_next = SW_UNIT(wu0 + NGW); SW_QLOAD(wu_next); }
        {
            constexpr int OSTR = 144;
            bf16_t* og = P.O + ((size_t)b * SEQ + 32 * rb) * P.opitch + hh * 128;
#pragma unroll
            for (int h = 0; h < 2; ++h) {
#pragma unroll
                for (int dd = 0; dd < 2; ++dd)
#pragma unroll
                    for (int g = 0; g < 4; ++g) { const int d = 2 * h + dd;
                        *(LAS u32x2*)(wl + r32 * OSTR + (dd * 32 + 8 * g + 4 * hi) * 2) = (u32x2){pk2(o[d][4 * g], o[d][4 * g + 1]), pk2(o[d][4 * g + 2], o[d][4 * g + 3])}; }
                LDS_WAIT();
#pragma unroll
                for (int i = 0; i < 4; ++i) { const int row = 8 * i + (lane >> 3), ch = lane & 7;
                    const u32x4 v = *(const LAS u32x4*)(wl + row * OSTR + ch * 16);
                    *(u32x4*)(og + (size_t)row * P.opitch + h * 64 + ch * 8) = v; }
                LDS_WAIT();
            }
        }
    }
#undef SW_UNIT
#undef SW_QLOAD
}

template <int MODE>
DI_ void attn_phase(LAS unsigned char* lds, const AttnP& P, int G, int bid) {
    if (__builtin_amdgcn_readfirstlane(threadIdx.x >> 6) >= 4) __builtin_amdgcn_s_setprio(1); else __builtin_amdgcn_s_setprio(0);
    if constexpr (MODE == 0) { const int total = 4 * P.nh * 16;
        for (int L = bid; L < total; L += G) { const int qb = (L >> 3) & 15, bh = (L & 7) + 8 * (L >> 7); attn_unit<MODE>(lds, P, bh / P.nh, bh % P.nh, qb); }
    } else { const int total = 4 * P.nh * 16;
        for (int L2 = 2 * bid; L2 < total; L2 += (L2 & 1) ? 2 * G - 1 : 1) { const int L = L2 >> 1, bh = (L & 7) + 8 * (L >> 6); int x = (L >> 3) & 7;
            if (MODE == 2 && (G & 63) == 0 && (((L - bid) / G) & 1)) x = 7 - x;
            attn_unit<MODE>(lds, P, bh / P.nh, bh % P.nh, (L2 & 1) ? 15 - x : x); }
    }
    __builtin_amdgcn_s_setprio(0);
}
struct Params { const float* in[20]; float* out; unsigned char* ws; int ph_lo, ph_hi; };
#ifndef DBG_MASK
#define DBG_MASK 0xFFFF
#endif
#define EN(k) (((DBG_MASK) >> (k)) & 1)
enum { SUB_N = 0, SUB_G1 = 1, SUB_A = 2, SUB_G3 = 3, SUB_G4 = 4, SUB_GLAT = 5, SUB_N1B = 6, SUB_G2 = 7, SUB_KN = 8, SUB_FINAL = 9 };

typedef const __attribute__((address_space(4))) Params* KParams;
DI_ KParams kparams() { auto kp = __builtin_amdgcn_kernarg_segment_ptr(); asm volatile("" : "+s"(kp)); return (KParams)kp; }
#define WSPTRS() KParams kp_ = kparams(); unsigned char* ws = kp_->ws; float* xout = kp_->out; \
    bf16_t* WB = (bf16_t*)(ws + WS_WB); bf16_t* Hb = (bf16_t*)(ws + WS_H); bf16_t* Qb = (bf16_t*)(ws + WS_Q); bf16_t* Kb = (bf16_t*)(ws + WS_K); bf16_t* VTb = (bf16_t*)(ws + WS_VT); \
    float* CS = (float*)(ws + WS_CS); float* LF = (float*)(ws + WS_LF); float* CUM = (float*)(ws + WS_CUM); \
    float* LAT = (float*)(ws + WS_LAT); bf16_t* QG = (bf16_t*)(ws + WS_QG); bf16_t* KL = (bf16_t*)(ws + WS_KL); bf16_t* KVNT = (bf16_t*)(ws + WS_KVNT); \
    bf16_t* QN = (bf16_t*)(ws + WS_QN); bf16_t* KVN = (bf16_t*)(ws + WS_KVN); \
    float* KNL = (float*)(ws + 65536); \
    const float* xin = (l == 0) ? kp_->in[0] : xout; \
    (void)WB; (void)Hb; (void)Qb; (void)Kb; (void)VTb; (void)CS; (void)LF; (void)CUM; (void)LAT; (void)QG; (void)KL; (void)KVNT; (void)QN; (void)KVN; (void)KNL; (void)xin; (void)xout
#define PIN(i) (kp_->in[i])
__global__ void __launch_bounds__(512) fwd_megakernel(Params p) {
    extern __shared__ __attribute__((aligned(16))) unsigned char lds_raw[];
    LAS unsigned char* lds = (LAS unsigned char*)lds_raw;
    cg::grid_group grid = cg::this_grid();
    const int G = gridDim.x, bid = blockIdx.x, NGW = G * 8;
    const int ph_hi = p.ph_hi;
    if (threadIdx.x < 64) ((LAS unsigned*)(lds + LDS_CTL_OFF))[threadIdx.x] = 0u;
    __syncthreads();
    const XcdBarrier xbar = xcd_barrier_post((unsigned*)p.ws, (volatile LAS unsigned*)(lds + LDS_CTL_OFF));
#ifdef DBG_REPEAT
    bool rep_done = false;
#endif
    for (int ph = p.ph_lo; ph < ph_hi; ++ph) {
        int tid_ = threadIdx.x; asm volatile("" : "+v"(tid_));
        const int tid = tid_, lane = tid & 63, wave = __builtin_amdgcn_readfirstlane(tid >> 6), gw = bid * 8 + wave;
        int l, sub, grp = 0;
        if (ph < 5) { l = 0; sub = ph; }
        else if (ph < 12) { l = 1; const int s = ph - 5; sub = s == 0 ? SUB_N : s == 1 ? SUB_GLAT : s == 2 ? SUB_N1B : s == 3 ? SUB_G2 : s == 4 ? SUB_A : s == 5 ? SUB_G3 : SUB_G4; }
        else if (ph < 17) { l = 2; sub = ph - 12; }
        else if (ph < 22) { l = 3; sub = ph - 17; }
        else { l = 4; sub = SUB_FINAL; }

        if (EN(0) && sub == SUB_N) { WSPTRS();
            LAS float* scr = (LAS float*)(lds + wave * 16384);
            if (l == 1) {
                const float* w_in = PIN(6);
                conv_seg(w_in, 2496, 1024, 0, 2496, WB + WB1_LAT, 0, scr, gw, NGW, lane);
                for (int it = gw; it < 256; it += NGW) {
                    if (it < 128) { const int h = it >> 3, kb = (it >> 1) & 3, nb = it & 1; tr_item(PIN(8), 3072, 256, 64 * kb, h * 192 + 128 + 32 * nb, WB + WB1_Q, h * 192 + 128 + 32 * nb, scr, lane); }
                    else { const int i2 = it - 128, kb = i2 >> 6, hb = i2 & 63, head = hb >> 2, dsub = hb & 3; tr_item(PIN(10), 4096, 128, 64 * kb, head * 256 + 128 + 32 * dsub, WB + WB1_V, head * 128 + 32 * dsub, scr, lane); } }
                conv_seg(PIN(11), 1024, 2048, 0, 1024, WB + WB1_O, 0, scr, gw, NGW, lane);
            } else {
                const float* w_in = l == 0 ? PIN(3) : l == 2 ? PIN(13) : PIN(17); const float* w_out = l == 0 ? PIN(4) : l == 2 ? PIN(15) : PIN(18);
                conv_seg(w_in, l == 2 ? 8208 : 8192, 1024, 0, 8192, WB + WB_IN, 0, scr, gw, NGW, lane);
                conv_seg(w_out, 1024, 2048, 0, 1024, WB + WB_O, 0, scr, gw, NGW, lane);
            }
            const float* gain = l == 0 ? PIN(2) : l == 1 ? PIN(5) : l == 2 ? PIN(12) : PIN(16);
            LAS float* wfl = (LAS float*)lds;
            if (l == 2) { __syncthreads();
                for (int idx = tid; idx < 16384; idx += 512) { const int k = idx >> 4, jj = idx & 15; wfl[jj * 1024 + k] = PIN(13)[(size_t)k * 8208 + 8192 + jj]; }
                __syncthreads(); }
            f32x4 nv[4], gg4[4];
#pragma unroll
            for (int jj = 0; jj < 4; ++jj) { gg4[jj] = *(const f32x4*)(gain + 4 * lane + 256 * jj); nv[jj] = gw < T ? *(const f32x4*)(xin + (size_t)gw * DM + 4 * lane + 256 * jj) : (f32x4){0.f, 0.f, 0.f, 0.f}; }
            for (int m = gw; m < T; m += NGW) {
                f32x4 v[4]; float s = 0.f;
#pragma unroll
                for (int jj = 0; jj < 4; ++jj) { v[jj] = nv[jj]; s += (v[jj].x * v[jj].x + v[jj].y * v[jj].y) + (v[jj].z * v[jj].z + v[jj].w * v[jj].w); }
                if (m + NGW < T) {
#pragma unroll
                    for (int jj = 0; jj < 4; ++jj) nv[jj] = *(const f32x4*)(xin + (size_t)(m + NGW) * DM + 4 * lane + 256 * jj); }
                const float r = 1.0f / sqrtf(wave_sum(s) * (1.0f / DM) + EPS);
#pragma unroll
                for (int jj = 0; jj < 4; ++jj) { const f32x4 gg = gg4[jj]; v[jj] = (v[jj] * r) * gg;
                    *(u32x2*)(Hb + (size_t)m * DM + 4 * lane + 256 * jj) = (u32x2){pk2(v[jj].x, v[jj].y), pk2(v[jj].z, v[jj].w)}; }
                if (l == 2) {
                    float a16[16];
#pragma unroll
                    for (int jh = 0; jh < 16; ++jh) { float a = 0.f;
#pragma unroll
                        for (int jj = 0; jj < 4; ++jj) { const f32x4 w = *(const LAS f32x4*)(wfl + jh * 1024 + 4 * lane + 256 * jj); a += (v[jj].x * w.x + v[jj].y * w.y) + (v[jj].z * w.z + v[jj].w * w.w); }
                        a16[jh] = a; }
                    float a8[8], a4[4], a2[2], a1;
                    { const bool up = (lane & 32) != 0;
#pragma unroll
                      for (int i = 0; i < 8; ++i) { const float keep = up ? a16[8 + i] : a16[i], send = up ? a16[i] : a16[8 + i]; a8[i] = keep + __shfl_xor(send, 32); } }
                    { const bool up = (lane & 16) != 0;
#pragma unroll
                      for (int i = 0; i < 4; ++i) { const float keep = up ? a8[4 + i] : a8[i], send = up ? a8[i] : a8[4 + i]; a4[i] = keep + __shfl_xor(send, 16); } }
                    { const bool up = (lane & 8) != 0;
#pragma unroll
                      for (int i = 0; i < 2; ++i) { const float keep = up ? a4[2 + i] : a4[i], send = up ? a4[i] : a4[2 + i]; a2[i] = keep + __shfl_xor(send, 8); } }
                    { const bool up = (lane & 4) != 0; const float keep = up ? a2[1] : a2[0], send = up ? a2[0] : a2[1]; a1 = keep + __shfl_xor(send, 4); }
                    a1 += __shfl_xor(a1, 2); a1 += __shfl_xor(a1, 1);
                    if ((lane & 3) == 0) { const int jh = ((lane >> 5) & 1) * 8 + ((lane >> 4) & 1) * 4 + ((lane >> 3) & 1) * 2 + ((lane >> 2) & 1);
                        const float f = a1 + PIN(14)[jh]; LF[(size_t)m * 16 + jh] = -(fmaxf(-f, 0.f) + log1pf(expf(-fabsf(f)))); } }
            }
            if (l == 2) __syncthreads();
        } else if (EN(1) && (sub == SUB_G1 || sub == SUB_G2)) { WSPTRS();
            if (l == 2 && bid < 64) {
                const int b = bid >> 4, h = bid & 15; float v[8]; float run = 0.f;
#pragma unroll
                for (int e = 0; e < 8; ++e) { run += LF[((size_t)b * SEQ + 8 * tid + e) * 16 + h]; v[e] = run; }
                float inc = run;
#pragma unroll
                for (int o = 1; o < 64; o <<= 1) { const float t = __shfl_up(inc, o); if (lane >= o) inc += t; }
                LAS float* wt = (LAS float*)lds;
                if (lane == 63) wt[wave] = inc;
                __syncthreads();
                float off = inc - run;
                for (int w = 0; w < wave; ++w) off += wt[w];
                float* cp = CUM + ((size_t)b * NH + h) * SEQ + 8 * tid;
                *(f32x4*)cp = (f32x4){v[0] + off, v[1] + off, v[2] + off, v[3] + off} * (-LOG2E); *(f32x4*)(cp + 4) = (f32x4){v[4] + off, v[5] + off, v[6] + off, v[7] + off} * (-LOG2E);
                __syncthreads();
            }
            const int ng = 2;
            for (int gi = 0; gi < ng; ++gi) {
                pg8::Gemm g; pg8::EpiBf16K E; E.split_cols = 0; E.split_stride = 0; E.knp = nullptr;
                if (sub == SUB_G1) {
                    if (gi == 0) { g = pg8::Gemm{Hb, WB + WB_IN, T, l == 2 ? 4096 : 6144, 1024}; E.O = Qb; E.ldc = 2048; E.split_cols = 2048; E.split_stride = (size_t)(WS_K - WS_Q) / 2; if (l == 2) E.knp = CS; }
                    else { if (l != 2) continue; g = pg8::Gemm{WB + WB_IN + (size_t)4096 * 1024, Hb, 2048, T, 1024}; E.O = VTb; E.ldc = T; }
                } else {
                    if (gi == 0) { g = pg8::Gemm{QN, WB + WB1_Q, T, 3072, 256}; E.O = QG; E.ldc = 3072; }
                    else continue;
                }
                pg8::StaticOrder S; S.init(g.M, g.N, G, bid);
                pg8::gemm_phase<pg8::EpiBf16K, pg8::StaticOrder, true, true>(lds, g, S, E);
            }
        } else if (EN(2) && sub == SUB_GLAT) { WSPTRS();
            { const int jb0 = G > 128 ? bid - 128 : bid, jbs = G > 128 ? G - 128 : G;
              if (jb0 >= 0) {
                {
                const int* pos = (const int*)PIN(1);
                for (int idx = jb0 * 512 + tid; idx < T * 32; idx += jbs * 512) { const int tok = idx >> 5, i = idx & 31;
                    const float invf = powf(10000.0f, -(float)(2 * i) / 64.0f); const float ang = (float)pos[tok] * invf;
                    const double ad = (double)ang, kq = rint(ad * 0.15915494309189535); const float rf = (float)(ad - kq * 6.283185307179586);
                    CS[idx] = cosf(rf); CS[(size_t)T * 32 + idx] = sinf(rf); }
                }
                { LAS float* wkv = (LAS float*)lds; LAS float* wql = wkv + 128 * 132;
                  for (int job = jb0; job < 128; job += jbs) { const int h = job >> 3, kg = job & 7;
                      for (int idx = tid; idx < 128 * 32; idx += 512) { const int c = idx >> 5, d4 = idx & 31; *(LAS f32x4*)(wkv + c * 132 + 4 * d4) = *(const f32x4*)(PIN(10) + (size_t)c * 4096 + h * 256 + 4 * d4); }
                      for (int idx = tid; idx < 32 * 32; idx += 512) { const int kl = idx >> 5, d4 = idx & 31; *(LAS f32x4*)(wql + kl * 132 + 4 * d4) = *(const f32x4*)(PIN(8) + (size_t)(kg * 32 + kl) * 3072 + h * 192 + 4 * d4); }
                      __syncthreads();
                      const int kl = tid >> 4, cg = tid & 15; float acc[8];
#pragma unroll
                      for (int i = 0; i < 8; ++i) acc[i] = 0.f;
#pragma unroll 4
                      for (int d4 = 0; d4 < 32; ++d4) { const f32x4 q = *(const LAS f32x4*)(wql + kl * 132 + 4 * d4);
#pragma unroll
                          for (int i = 0; i < 8; ++i) { const f32x4 w = *(const LAS f32x4*)(wkv + (cg + 16 * i) * 132 + 4 * d4); acc[i] += (q.x * w.x + q.y * w.y) + (q.z * w.z + q.w * w.w); } }
#pragma unroll
                      for (int i = 0; i < 8; ++i) WB[WB1_Q + (size_t)(h * 192 + cg + 16 * i) * 256 + kg * 32 + kl] = (bf16_t)(pk2(acc[i], 0.f) & 0xffffu);
                      __syncthreads(); } }
              } }
            pg8::Gemm g{Hb, WB + WB1_LAT, T, 512, 1024}; pg8::EpiF32<false> E{nullptr, LAT, 512};
            pg8::StaticOrder S; S.init(g.M, g.N, G, bid);
            pg8::gemm_phase<pg8::EpiF32<false>, pg8::StaticOrder, true, true>(lds, g, S, E);
        } else if (EN(9) && sub == SUB_G4) { WSPTRS();
            bf16_t* A = Qb;
            pg8::Gemm g{A, WB + (l == 1 ? WB1_O : WB_O), T, 1024, 2048}; pg8::EpiF32<true> E{xin, xout, 1024};
            pg8::StaticOrder S; S.init(g.M, g.N, G, bid);
            pg8::gemm_phase<pg8::EpiF32<true>, pg8::StaticOrder, true, true>(lds, g, S, E);
        } else if (EN(3) && sub == SUB_G3) { WSPTRS();
            pg8::Gemm g{Hb, WB + (l == 1 ? WB1_G : WB_IN + (size_t)6144 * 1024), T, 2048, 1024}; pg8::EpiGate E{Qb, 2048};
            pg8::StaticOrder S; S.init(g.M, g.N, G, bid);
            pg8::gemm_phase<pg8::EpiGate, pg8::StaticOrder, true, true>(lds, g, S, E);
        } else if (EN(4) && sub == SUB_N1B) { WSPTRS();
            const f32x4 gq = *(const f32x4*)(PIN(7) + 4 * lane), gk = *(const f32x4*)(PIN(9) + 4 * (lane & 31));
            f32x4 na = (f32x4){0.f, 0.f, 0.f, 0.f}, nb = na;
            if (gw < T) { na = *(const f32x4*)(LAT + (size_t)gw * 512 + 4 * lane); nb = *(const f32x4*)(LAT + (size_t)gw * 512 + 256 + 4 * lane); }
            for (int m = gw; m < T; m += NGW) {
                const f32x4 a = na, bq = nb;
                if (m + NGW < T) { na = *(const f32x4*)(LAT + (size_t)(m + NGW) * 512 + 4 * lane); nb = *(const f32x4*)(LAT + (size_t)(m + NGW) * 512 + 256 + 4 * lane); }
                const float rq = 1.0f / sqrtf(wave_sum((a.x * a.x + a.y * a.y) + (a.z * a.z + a.w * a.w)) * (1.0f / 256.0f) + EPS);
                const f32x4 yq = (a * rq) * gq;
                *(u32x2*)(QN + (size_t)m * 256 + 4 * lane) = (u32x2){pk2(yq.x, yq.y), pk2(yq.z, yq.w)};
                const float sk = lane < 32 ? (bq.x * bq.x + bq.y * bq.y) + (bq.z * bq.z + bq.w * bq.w) : 0.f;
                const float rk = 1.0f / sqrtf(wave_sum(sk) * (1.0f / 128.0f) + EPS);
                float kk2 = 0.f;
                if (lane < 32) { const f32x4 yk = (bq * rk) * gk; kk2 = (yk.x * yk.x + yk.y * yk.y) + (yk.z * yk.z + yk.w * yk.w);
                    *(u32x2*)(KL + (size_t)m * 192 + 4 * lane) = (u32x2){pk2(yk.x, yk.y), pk2(yk.z, yk.w)}; }
                f32x4 pr; pr.x = __shfl_xor(bq.x, 8); pr.y = __shfl_xor(bq.y, 8); pr.z = __shfl_xor(bq.z, 8); pr.w = __shfl_xor(bq.w, 8);
                if (lane >= 32 && lane < 48) { const int i0 = 4 * (lane & 7); const bool second = lane >= 40;
                    const f32x4 c = *(const f32x4*)(CS + (size_t)m * 32 + i0), s = *(const f32x4*)(CS + (size_t)T * 32 + (size_t)m * 32 + i0);
                    const f32x4 x1 = second ? pr : bq, x2 = second ? bq : pr;
                    const f32x4 y = second ? (x1 * s + x2 * c) : (x1 * c - x2 * s);
                    *(u32x2*)(KL + (size_t)m * 192 + 128 + 4 * (lane - 32)) = (u32x2){pk2(y.x, y.y), pk2(y.z, y.w)}; kk2 = (y.x * y.x + y.y * y.y) + (y.z * y.z + y.w * y.w); }
                kk2 = wave_sum(kk2); if (lane == 0) KNL[m] = kk2;
            }
        } else if (sub == SUB_A) { WSPTRS();
            AttnP P; P.cum = CUM; P.cs = CS; P.KR = nullptr; P.kn2 = CS;
            P.khead = 128; P.vheadrows = 128; P.krpitch = 64; P.WV = WB + WB1_V;
            if (EN(6) && l == 1) { P.Q = QG; P.K = KL; P.KR = KL + 128; P.VT = KVNT; P.O = Qb; P.qpitch = 3072; P.kpitch = 192; P.krpitch = 192; P.khead = 0; P.vheadrows = 0; P.opitch = 2048; P.nh = 16; P.kn2 = KNL;
#if defined(DBG_REPEAT) && defined(DBG_VAR)
                attn_phase<1>(lds, P, G, bid, (ph == DBG_REPEAT && !rep_done) ? DBG_VAR : 0); }
#else
                attn_phase<1>(lds, P, G, bid); }
#endif
            else { P.Q = Qb; P.K = Kb; P.VT = VTb; P.O = Qb; P.qpitch = 2048; P.kpitch = 2048; P.opitch = 2048; P.nh = 16;
                if (EN(7) && l == 2) attn_phase<2>(lds, P, G, bid); else if (EN(5)) {
                    stick_wave_phase(lds, P, gw, NGW);
                } }
        } else if (EN(8)) { WSPTRS();
            f32x4 nv[4], gg4[4];
#pragma unroll
            for (int jj = 0; jj < 4; ++jj) { gg4[jj] = *(const f32x4*)(PIN(19) + 4 * lane + 256 * jj); nv[jj] = gw < T ? *(const f32x4*)(xout + (size_t)gw * DM + 4 * lane + 256 * jj) : (f32x4){0.f, 0.f, 0.f, 0.f}; }
            for (int m = gw; m < T; m += NGW) {
                float* xr = xout + (size_t)m * DM + 4 * lane; f32x4 v[4]; float s = 0.f;
#pragma unroll
                for (int jj = 0; jj < 4; ++jj) { v[jj] = nv[jj]; s += (v[jj].x * v[jj].x + v[jj].y * v[jj].y) + (v[jj].z * v[jj].z + v[jj].w * v[jj].w); }
                if (m + NGW < T) {
#pragma unroll
                    for (int jj = 0; jj < 4; ++jj) nv[jj] = *(const f32x4*)(xout + (size_t)(m + NGW) * DM + 4 * lane + 256 * jj); }
                const float r = 1.0f / sqrtf(wave_sum(s) * (1.0f / DM) + EPS);
#pragma unroll
                for (int jj = 0; jj < 4; ++jj) *(f32x4*)(xr + 256 * jj) = (v[jj] * r) * gg4[jj];
            }
        }
        if (ph + 1 < ph_hi) { if (p.ph_lo < 0) grid.sync(); else xcd_barrier(xbar); }
#ifdef DBG_REPEAT
        if (ph == DBG_REPEAT && !rep_done) { rep_done = true; --ph; }
#endif
    }
}

extern "C" void kernel_launch(void* const* d_in, const int* in_sizes, int n_in, void* d_out, int out_size, void* d_ws, size_t ws_size, hipStream_t stream) {
    static int grid = 0;
    if (grid == 0) {
        if (n_in != 20 || in_sizes[0] != T * DM || out_size != T * DM || ws_size < WS_END) { fprintf(stderr, "kernel_launch: unexpected shapes (n_in %d, in0 %d, out %d, ws %zu)\n", n_in, n_in > 0 ? in_sizes[0] : -1, out_size, ws_size); grid = -1; return; }
        int dev = 0, cus = 0, per_cu = 0;
        (void)hipGetDevice(&dev); (void)hipDeviceGetAttribute(&cus, hipDeviceAttributeMultiprocessorCount, dev);
        if (hipFuncSetAttribute((const void*)fwd_megakernel, hipFuncAttributeMaxDynamicSharedMemorySize, LDS_BYTES) != hipSuccess) { fprintf(stderr, "kernel_launch: hipFuncSetAttribute failed\n"); grid = -1; return; }
        if (hipOccupancyMaxActiveBlocksPerMultiprocessor(&per_cu, (const void*)fwd_megakernel, 512, LDS_BYTES) != hipSuccess || per_cu < 1) { fprintf(stderr, "kernel_launch: occupancy query says %d\n", per_cu); per_cu = 1; }
        (void)hipGetLastError();
        if (cus <= 0) cus = 256;
        grid = cus;
    }
    if (grid < 0) return;
    if (hipMemsetAsync(d_ws, 0, 16384, stream) != hipSuccess) { fprintf(stderr, "kernel_launch: memset failed\n"); return; }
    Params p{};
    for (int i = 0; i < 20; ++i) p.in[i] = (const float*)d_in[i];
    p.out = (float*)d_out; p.ws = (unsigned char*)d_ws;
#if MK_ONE_LAUNCH
    p.ph_lo = 0; p.ph_hi = NPH;
    void* args[] = {&p};
    hipError_t e = hipLaunchCooperativeKernel((const void*)fwd_megakernel, dim3(grid), dim3(512), args, LDS_BYTES, stream);
    if (e != hipSuccess) fprintf(stderr, "kernel_launch: cooperative launch failed: %s (grid %d)\n", hipGetErrorString(e), grid);
#else
    for (int ph = 0; ph < NPH; ++ph) { p.ph_lo = ph; p.ph_hi = ph + 1; hipLaunchKernelGGL(fwd_megakernel, dim3(grid), dim3(512), LDS_BYTES, stream, p); }
#endif
}
```
